# Optimizing an MI355X kernel written in HIP

```python
import jax, jax.numpy as jnp
from jax import lax
import numpy as np

D_MODEL = 1024
BATCH = 2
SEQ = 16384
DEPTH = 4

CHUNK = 64
HEAD_DIM = 64
RET_W = D_MODEL // 2
SB_W = D_MODEL // 4
RWKV_W = D_MODEL - RET_W - SB_W
RET_HEADS = RET_W // HEAD_DIM
SB_HEADS = SB_W // HEAD_DIM
RWKV_HEADS = RWKV_W // HEAD_DIM
MIX_W = RET_W + SB_W + RWKV_W
DECAY_LORA = 64
AAA_LORA = 64
GATE_LORA = 128
RWKV_IN = 3 * RWKV_W + DECAY_LORA + AAA_LORA + GATE_LORA
RET_IN = 4 * RET_W
SB_IN = 3 * SB_W
IN_W = RET_IN + SB_IN + RWKV_IN
D_FF = 4 * D_MODEL
PLE_DIM = 256
SB_BLOCK = 128
ROPE_BASE = 10000.0
NORM_EPS = 1e-6
RWKV_GN_EPS = 64e-5

kernel_name = "hybrid_retention_stickbreaking_rwkv7_trunk"

F32 = jnp.float32


def rms_norm(x, g):
    xf = x.astype(F32)
    y = xf * lax.rsqrt(jnp.mean(xf * xf, axis=-1, keepdims=True) + NORM_EPS)
    return (y * g.astype(F32)).astype(x.dtype)


def rope(t, cos, sin):
    t1, t2 = jnp.split(t, 2, axis=-1)
    return jnp.concatenate([t1 * cos - t2 * sin, t1 * sin + t2 * cos], axis=-1)


def retention(q, k, v, g, norm_g):
    B, S, _ = q.shape
    H, Dh, L = RET_HEADS, HEAD_DIM, CHUNK
    C = S // L
    q = q.astype(F32).reshape(B, S, H, Dh)
    k = k.astype(F32).reshape(B, S, H, Dh)
    v = v.astype(F32).reshape(B, S, H, Dh)
    pos = jnp.arange(S, dtype=F32)
    inv_freq = 1.0 / (ROPE_BASE ** jnp.linspace(0.0, 1.0, Dh // 2, dtype=F32))
    ang = pos[:, None] * inv_freq[None, :]
    cos = jnp.cos(ang)[:, None, :]
    sin = jnp.sin(ang)[:, None, :]
    q = rope(q, cos, sin)
    k = rope(k, cos, sin) * (Dh ** -0.5)
    log_g = jnp.log(1.0 - jnp.exp2(-5.0 - jnp.arange(H, dtype=F32)))
    i = jnp.arange(L, dtype=F32)
    intra_decay = jnp.exp(jnp.abs(i[:, None] - i[None, :])[None] * log_g[:, None, None])
    qc = q.reshape(B, C, L, H, Dh)
    kc = k.reshape(B, C, L, H, Dh)
    vc = v.reshape(B, C, L, H, Dh)
    scores = jnp.einsum('bcihd,bcjhd->bchij', qc, kc) * intra_decay
    o_intra = jnp.einsum('bchij,bcjhd->bcihd', scores, vc)
    k_dec = jnp.exp((L - 1 - i)[:, None] * log_g[None, :])
    kv = jnp.einsum('bcjhd,bcjhe->cbhde', kc * k_dec[:, :, None], vc)
    chunk_decay = jnp.exp(L * log_g)[None, :, None, None]

    def step(state, kv_c):
        return state * chunk_decay + kv_c, state

    _, r_prev = lax.scan(step, jnp.zeros((B, H, Dh, Dh), F32), kv)
    q_dec = jnp.exp((i + 1)[:, None] * log_g[None, :])
    o_cross = jnp.einsum('bcihd,cbhde->bcihe', qc * q_dec[:, :, None], r_prev)
    o = (o_intra + o_cross).reshape(B, S, H, Dh)
    o = o * lax.rsqrt(jnp.mean(o * o, axis=-1, keepdims=True) + NORM_EPS)
    o = o.reshape(B, S, RET_W) * norm_g.astype(F32)
    return jax.nn.silu(g.astype(F32)) * o


def stick_breaking(q, k, v):
    B, S, _ = q.shape
    H, Dh, T = SB_HEADS, HEAD_DIM, SB_BLOCK
    nb = S // T
    qh = q.astype(F32).reshape(B, S, H, Dh).transpose(0, 2, 1, 3) * (Dh ** -0.5)
    kh = k.astype(F32).reshape(B, S, H, Dh).transpose(0, 2, 1, 3)
    vh = v.astype(F32).reshape(B, S, H, Dh).transpose(0, 2, 1, 3)
    strict = jnp.asarray(np.tril(np.ones((T, T), dtype=bool), -1))
    rev_incl = jnp.asarray(np.tril(np.ones((T, T), dtype=np.float32)))
    outs = []
    for qi in range(nb):
        lo, hi = qi * T, (qi + 1) * T
        qb = qh[:, :, lo:hi]
        zd = jnp.einsum('bhtd,bhsd->bhts', qb, kh[:, :, lo:hi])
        lsd = jnp.where(strict, -jax.nn.softplus(zd), 0.0)
        cumd = jnp.einsum('bhtj,js->bhts', lsd, rev_incl)
        wd = jnp.where(strict, jnp.exp(zd + cumd), 0.0)
        o = jnp.einsum('bhts,bhsd->bhtd', wd, vh[:, :, lo:hi])
        if qi > 0:
            tot_d = jnp.sum(lsd, axis=-1)
            kp = kh[:, :, :lo].reshape(B, H, qi, T, Dh)
            vp = vh[:, :, :lo].reshape(B, H, qi, T, Dh)
            zp = jnp.einsum('bhtd,bhnsd->bhtns', qb, kp)
            lsp = -jax.nn.softplus(zp)
            tot_p = jnp.sum(lsp, axis=-1)
            later_blocks = jnp.asarray(np.tril(np.ones((qi, qi), dtype=np.float32), -1))
            after = jnp.einsum('bhtm,mn->bhtn', tot_p, later_blocks) + tot_d[..., None]
            cump = jnp.einsum('bhtnj,js->bhtns', lsp, rev_incl) + after[..., None]
            wp = jnp.exp(zp + cump)
            o = o + jnp.einsum('bhtns,bhnsd->bhtd', wp, vp)
        outs.append(o)
    o = jnp.concatenate(outs, axis=2)
    return o.transpose(0, 2, 1, 3).reshape(B, S, SB_W)


def rwkv7(z, mu, w0, w_up, a0, a_up, g_up, k_k, k_a, r_k, ln_w, ln_b):
    B, S, _ = z.shape
    H, N, W = RWKV_HEADS, HEAD_DIM, RWKV_W
    z = z.astype(F32)
    z_prev = jnp.pad(z, ((0, 0), (1, 0), (0, 0)))[:, :-1]
    z = z + mu.astype(F32) * (z_prev - z)
    r, k, v, wd, ad, gd = jnp.split(
        z, [W, 2 * W, 3 * W, 3 * W + DECAY_LORA, 3 * W + DECAY_LORA + AAA_LORA], axis=-1)
    log_w = -jax.nn.softplus(-(w0.astype(F32) + jnp.tanh(wd) @ w_up.astype(F32))) - 0.5
    decay = jnp.exp(-jnp.exp(log_w))
    a = jax.nn.sigmoid(a0.astype(F32) + ad @ a_up.astype(F32))
    g = jax.nn.sigmoid(gd) @ g_up.astype(F32)

    def heads(t):
        return t.reshape(B, S, H, N)

    kk = heads(k * k_k.astype(F32))
    kk = kk / jnp.maximum(jnp.sqrt(jnp.sum(kk * kk, axis=-1, keepdims=True)), 1e-12)
    k_mod = heads(k * (1.0 + (a - 1.0) * k_a.astype(F32)))
    r_h, v_h, w_h, a_h = heads(r), heads(v), heads(decay), heads(a)
    xs = tuple(t.transpose(1, 0, 2, 3) for t in (r_h, w_h, k_mod, v_h, -kk, kk * a_h))

    def step(state, inp):
        rt, wt, kt, vt, at, bt = inp
        sa = jnp.einsum('bhvk,bhk->bhv', state, at)
        state = state * wt[:, :, None, :] + sa[..., None] * bt[:, :, None, :] + vt[..., None] * kt[:, :, None, :]
        return state, jnp.einsum('bhvk,bhk->bhv', state, rt)

    _, ys = lax.scan(step, jnp.zeros((B, H, N, N), F32), xs)
    y = ys.transpose(1, 0, 2, 3)
    mean = jnp.mean(y, axis=-1, keepdims=True)
    var = jnp.mean(jnp.square(y - mean), axis=-1, keepdims=True)
    y = ((y - mean) * lax.rsqrt(var + RWKV_GN_EPS)).reshape(B, S, W)
    y = y * ln_w.astype(F32) + ln_b.astype(F32)
    bonus = jnp.sum(r_h * k_mod * r_k.astype(F32).reshape(H, N), axis=-1, keepdims=True) * v_h
    y = y + bonus.reshape(B, S, W)
    return y * g


def setup_inputs(seed: int = 0) -> dict:
    key = jax.random.key(seed)
    ks = jax.random.split(key, 26)
    nrm = lambda k, shape, s: jax.random.normal(k, shape, F32) * s
    ramp = -6.0 + 5.0 * (jnp.arange(HEAD_DIM, dtype=F32) / (HEAD_DIM - 1))
    w0_base = jnp.tile(ramp, RWKV_HEADS)[None, :]
    return {
        "x": nrm(ks[0], (BATCH, SEQ, D_MODEL), 1.0),
        "p": nrm(ks[1], (DEPTH, BATCH, SEQ, PLE_DIM), 1.0),
        "norm_mix_g": 1.0 + nrm(ks[2], (DEPTH, D_MODEL), 0.02),
        "norm_mlp_g": 1.0 + nrm(ks[3], (DEPTH, D_MODEL), 0.02),
        "norm_ple_g": 1.0 + nrm(ks[4], (DEPTH, D_MODEL), 0.02),
        "w_in": nrm(ks[5], (DEPTH, D_MODEL, IN_W), D_MODEL ** -0.5),
        "ret_norm_g": 1.0 + nrm(ks[6], (DEPTH, RET_W), 0.02),
        "rwkv_mu": jax.random.uniform(ks[7], (DEPTH, RWKV_IN), F32),
        "rwkv_w0": w0_base + nrm(ks[8], (DEPTH, RWKV_W), 0.1),
        "rwkv_w_up": nrm(ks[9], (DEPTH, DECAY_LORA, RWKV_W), 0.5 * DECAY_LORA ** -0.5),
        "rwkv_a0": nrm(ks[10], (DEPTH, RWKV_W), 0.1),
        "rwkv_a_up": nrm(ks[11], (DEPTH, AAA_LORA, RWKV_W), AAA_LORA ** -0.5),
        "rwkv_g_up": nrm(ks[12], (DEPTH, GATE_LORA, RWKV_W), GATE_LORA ** -0.5),
        "rwkv_k_k": 0.85 + nrm(ks[13], (DEPTH, RWKV_W), 0.02),
        "rwkv_k_a": 1.0 + nrm(ks[14], (DEPTH, RWKV_W), 0.02),
        "rwkv_r_k": nrm(ks[15], (DEPTH, RWKV_W), 0.1),
        "rwkv_ln_w": 1.0 + nrm(ks[16], (DEPTH, RWKV_W), 0.02),
        "rwkv_ln_b": nrm(ks[17], (DEPTH, RWKV_W), 0.02),
        "w_o": nrm(ks[18], (DEPTH, MIX_W, D_MODEL), MIX_W ** -0.5),
        "w_mlp_in": nrm(ks[19], (DEPTH, D_MODEL, D_FF), D_MODEL ** -0.5),
        "w_mlp_out": nrm(ks[20], (DEPTH, D_FF, D_MODEL), 0.5 * D_FF ** -0.5),
        "w_pe": nrm(ks[21], (DEPTH, PLE_DIM, D_MODEL), PLE_DIM ** -0.5),
        "w_pg": nrm(ks[22], (DEPTH, D_MODEL, D_MODEL), D_MODEL ** -0.5),
        "final_norm_g": 1.0 + nrm(ks[23], (D_MODEL,), 0.02),
    }


def reference(x, p, norm_mix_g, norm_mlp_g, norm_ple_g, w_in, ret_norm_g, rwkv_mu, rwkv_w0,
              rwkv_w_up, rwkv_a0, rwkv_a_up, rwkv_g_up, rwkv_k_k, rwkv_k_a, rwkv_r_k,
              rwkv_ln_w, rwkv_ln_b, w_o, w_mlp_in, w_mlp_out, w_pe, w_pg, final_norm_g):
    h = x
    for i in range(DEPTH):
        n = rms_norm(h, norm_mix_g[i])
        proj = n @ w_in[i]
        ret_in, sb_in, rwkv_in = jnp.split(proj, [RET_IN, RET_IN + SB_IN], axis=-1)
        rq, rk, rv, rg = jnp.split(ret_in, 4, axis=-1)
        sq, sk, sv = jnp.split(sb_in, 3, axis=-1)
        o_ret = retention(rq, rk, rv, rg, ret_norm_g[i])
        o_sb = stick_breaking(sq, sk, sv)
        o_rwkv = rwkv7(rwkv_in, rwkv_mu[i], rwkv_w0[i], rwkv_w_up[i], rwkv_a0[i], rwkv_a_up[i],
                       rwkv_g_up[i], rwkv_k_k[i], rwkv_k_a[i], rwkv_r_k[i], rwkv_ln_w[i], rwkv_ln_b[i])
        mix = jnp.concatenate([o_ret, o_sb, o_rwkv], axis=-1).astype(h.dtype)
        h = h + mix @ w_o[i]
        n = rms_norm(h, norm_mlp_g[i])
        h = h + jnp.square(jax.nn.relu(n @ w_mlp_in[i])) @ w_mlp_out[i]
        n = rms_norm(h, norm_ple_g[i])
        h = h + jax.nn.sigmoid(n @ w_pg[i]) * (p[i] @ w_pe[i])
    return rms_norm(h, final_norm_g)
```

```cpp
#include <hip/hip_runtime.h>
#include <hip/hip_cooperative_groups.h>
#include <cstdio>
#include <cstdint>
namespace cg = cooperative_groups;
namespace pg8 {
#define PG8_LAS __attribute__((address_space(3)))
typedef unsigned short bf16_t;
typedef short bf16x8 __attribute__((ext_vector_type(8)));
typedef float f32x4 __attribute__((ext_vector_type(4)));
typedef unsigned u32x4 __attribute__((ext_vector_type(4)));
constexpr int BM = 256, BK = 64, HALF = 128, HTB = HALF * BK * 2  , STAGE_BYTES = 8 * HTB, NXCD = 8, WGM = 8;

__host__ __device__ __forceinline__ int lds_byte(int r, int c) { const int st = (r >> 4) * 2 + (c >> 5), rr = r & 15, cc = c & 31, ob = rr * 64 + cc * 2; return st * 1024 + (ob ^ (((ob >> 9) & 1) << 5)); }
__host__ __device__ __forceinline__ void stage_rc(int b, int& R, int& C) { const int st = b / 1024, sb = b % 1024, swz = sb ^ (((sb >> 9) & 1) << 5); R = (st >> 1) * 16 + swz / 64; C = (st & 1) * 32 + (swz % 64) / 2; }
__host__ __device__ __forceinline__ int perm32(int rho) { const int n = rho >> 4, i = rho & 15; return 8 * (i >> 2) + 4 * n + (i & 3); }

struct Unit { int pm, pn; };
struct Gemm { const bf16_t* A; const bf16_t* Bt; int M, N, K; };

struct StaticOrder {
    int nM, nN, nwg, G, c;
    __host__ __device__ void init(int M, int N, int G_, int c_) { nM = M / BM; nN = N / BM; nwg = nM * nN; G = G_; c = c_; }
    __host__ __device__ bool next(int i, Unit& u) const {
        const long L = (long)i * G + c; if (L >= nwg) return false;
        int wgid = (int)L; { const int q = nwg / NXCD, r = nwg % NXCD, xcd = wgid % NXCD, off = wgid / NXCD; wgid = (xcd < r ? xcd * (q + 1) : r * (q + 1) + (xcd - r) * q) + off; }
        const int nig = WGM * nN, gid = wgid / nig, fm = gid * WGM, gsz = (nM - fm) < WGM ? (nM - fm) : WGM;
        u.pm = fm + ((wgid % nig) % gsz); u.pn = (wgid % nig) / gsz; return true;
    }
    __device__ __forceinline__ void a_ready(const Unit&) const {}
    __device__ __forceinline__ void done(const Unit&) const {}
};

__device__ __forceinline__ unsigned cvt_pk_bf16(float lo, float hi) { unsigned r; asm volatile("v_cvt_pk_bf16_f32 %0, %1, %2" : "=v"(r) : "v"(lo), "v"(hi)); return r; }
template <int ACT> struct EpiBf16 {
    static constexpr bool PERM = true, AFTER_DRAIN = false;
    bf16_t* O; int ldc;
    __device__ __forceinline__ void operator()(const f32x4 (&acc)[2][2][4][2], const Unit& u, int wr, int wc, int fr, int fq) const {
        const int row0 = u.pm * BM + wr * 64 + fr; const int col0 = u.pn * BM + wc * 32 + 8 * fq;
#pragma unroll
        for (int ai = 0; ai < 2; ++ai)
#pragma unroll
            for (int m = 0; m < 4; ++m) { bf16_t* rowp = O + (size_t)(row0 + ai * HALF + m * 16) * ldc + col0;
#pragma unroll
                for (int bj = 0; bj < 2; ++bj) { f32x4 v0 = acc[ai][bj][m][0], v1 = acc[ai][bj][m][1];
                    if (ACT == 1) {
#pragma unroll
                        for (int q = 0; q < 4; ++q) { float a = fmaxf(v0[q], 0.f), b = fmaxf(v1[q], 0.f); v0[q] = a * a; v1[q] = b * b; } }
                    u32x4 w; w.x = cvt_pk_bf16(v0[0], v0[1]); w.y = cvt_pk_bf16(v0[2], v0[3]); w.z = cvt_pk_bf16(v1[0], v1[1]); w.w = cvt_pk_bf16(v1[2], v1[3]);
                    *(u32x4*)(rowp + bj * HALF) = w; } }
    }
};
template <int GATE> struct EpiRes {
    static constexpr bool PERM = false, AFTER_DRAIN = false;
    const float* base; float* out; const bf16_t* pe; int ldc;
    __device__ __forceinline__ void operator()(const f32x4 (&acc)[2][2][4][2], const Unit& u, int wr, int wc, int fr, int fq) const {
        const int col0 = u.pn * BM + wc * 32 + 4 * fq;
#pragma unroll
        for (int ai = 0; ai < 2; ++ai)
#pragma unroll
            for (int m = 0; m < 4; ++m) { const size_t off = (size_t)(u.pm * BM + ai * HALF + wr * 64 + m * 16 + fr) * ldc + col0;
#pragma unroll
                for (int bj = 0; bj < 2; ++bj)
#pragma unroll
                    for (int n = 0; n < 2; ++n) { const size_t o2 = off + bj * HALF + n * 16; const f32x4 bs = *(const f32x4*)(base + o2); f32x4 a = acc[ai][bj][m][n];
                        if (GATE) { const uint2 pw = *(const uint2*)(pe + o2); float p0 = __uint_as_float(pw.x << 16), p1 = __uint_as_float(pw.x & 0xffff0000u), p2 = __uint_as_float(pw.y << 16), p3 = __uint_as_float(pw.y & 0xffff0000u);
                            a[0] = p0 / (1.f + __expf(-a[0])); a[1] = p1 / (1.f + __expf(-a[1])); a[2] = p2 / (1.f + __expf(-a[2])); a[3] = p3 / (1.f + __expf(-a[3])); }
                        *(f32x4*)(out + o2) = bs + a; } }
    }
};

struct EpiGen {
    static constexpr bool AFTER_DRAIN = false;
    int mode; bool perm; bf16_t* O; int ldc; const float* hbase; float* hout; bf16_t* hcopy; const bf16_t* pe; const unsigned long long* rss_in; unsigned long long* rss_out;
    __device__ __forceinline__ void operator()(const f32x4 (&acc)[2][2][4][2], const Unit& u, int wr, int wc, int fr, int fq) const {
        if (mode < 2) {
            const int row0 = u.pm * BM + wr * 64 + fr; const int col0 = u.pn * BM + wc * 32 + 8 * fq; const bool sq = (mode == 1);
#pragma unroll
            for (int ai = 0; ai < 2; ++ai)
#pragma unroll
                for (int m = 0; m < 4; ++m) { const int row = row0 + ai * HALF + m * 16; bf16_t* rowp = O + (size_t)row * ldc + col0;
                    const float rs = rss_in ? rsqrtf((float)rss_in[row] * (1.f / (1024.f * 1048576.f)) + 1e-6f) : 1.f;
#pragma unroll
                    for (int bj = 0; bj < 2; ++bj) { f32x4 v0 = acc[ai][bj][m][0] * rs, v1 = acc[ai][bj][m][1] * rs;
                        if (sq) {
#pragma unroll
                            for (int q = 0; q < 4; ++q) { float a = fmaxf(v0[q], 0.f), b = fmaxf(v1[q], 0.f); v0[q] = a * a; v1[q] = b * b; } }
                        u32x4 w; w.x = cvt_pk_bf16(v0[0], v0[1]); w.y = cvt_pk_bf16(v0[2], v0[3]); w.z = cvt_pk_bf16(v1[0], v1[1]); w.w = cvt_pk_bf16(v1[2], v1[3]);
                        if (sq) __builtin_nontemporal_store(w, (u32x4*)(rowp + bj * HALF)); else *(u32x4*)(rowp + bj * HALF) = w; } }
        } else {
            const int col0 = u.pn * BM + wc * 32 + 8 * fq; const bool gate = (mode == 3);
#pragma unroll
            for (int ai = 0; ai < 2; ++ai) {
#pragma unroll
              for (int mp = 0; mp < 2; ++mp) {
                f32x4 pre[4][2][2]; u32x4 pq_[2][2];
#pragma unroll
                for (int m = 2 * mp; m < 2 * mp + 2; ++m) { const size_t off = (size_t)(u.pm * BM + ai * HALF + wr * 64 + m * 16 + fr) * ldc + col0;
#pragma unroll
                    for (int bj = 0; bj < 2; ++bj)
#pragma unroll
                        for (int n = 0; n < 2; ++n) pre[m][bj][n] = __builtin_nontemporal_load((const f32x4*)(hbase + off + bj * HALF + n * 4));
                    if (gate) {
#pragma unroll
                        for (int bj = 0; bj < 2; ++bj) pq_[m & 1][bj] = *(const u32x4*)(pe + off + bj * HALF); } }
#pragma unroll
                for (int m = 2 * mp; m < 2 * mp + 2; ++m) { const int row = u.pm * BM + ai * HALF + wr * 64 + m * 16 + fr; const size_t off = (size_t)row * ldc + col0;
                    const float rs = gate ? rsqrtf((float)rss_in[row] * (1.f / (1024.f * 1048576.f)) + 1e-6f) : 1.f; float ssum = 0.f;
#pragma unroll
                    for (int bj = 0; bj < 2; ++bj) { const size_t o2 = off + bj * HALF; f32x4 a0 = acc[ai][bj][m][0], a1 = acc[ai][bj][m][1];
                        if (gate) { const u32x4 pq = pq_[m & 1][bj];
                            a0[0] = __uint_as_float(pq.x << 16) / (1.f + __expf(-a0[0] * rs)); a0[1] = __uint_as_float(pq.x & 0xffff0000u) / (1.f + __expf(-a0[1] * rs)); a0[2] = __uint_as_float(pq.y << 16) / (1.f + __expf(-a0[2] * rs)); a0[3] = __uint_as_float(pq.y & 0xffff0000u) / (1.f + __expf(-a0[3] * rs));
                            a1[0] = __uint_as_float(pq.z << 16) / (1.f + __expf(-a1[0] * rs)); a1[1] = __uint_as_float(pq.z & 0xffff0000u) / (1.f + __expf(-a1[1] * rs)); a1[2] = __uint_as_float(pq.w << 16) / (1.f + __expf(-a1[2] * rs)); a1[3] = __uint_as_float(pq.w & 0xffff0000u) / (1.f + __expf(-a1[3] * rs)); }
                        const f32x4 h0 = pre[m][bj][0] + a0, h1 = pre[m][bj][1] + a1;
                        ssum += ((h0[0] * h0[0] + h0[1] * h0[1]) + (h0[2] * h0[2] + h0[3] * h0[3])) + ((h1[0] * h1[0] + h1[1] * h1[1]) + (h1[2] * h1[2] + h1[3] * h1[3]));
                        __builtin_nontemporal_store(h0, (f32x4*)(hout + o2)); __builtin_nontemporal_store(h1, (f32x4*)(hout + o2 + 4));
                        u32x4 ow; ow.x = cvt_pk_bf16(h0[0], h0[1]); ow.y = cvt_pk_bf16(h0[2], h0[3]); ow.z = cvt_pk_bf16(h1[0], h1[1]); ow.w = cvt_pk_bf16(h1[2], h1[3]); *(u32x4*)(hcopy + o2) = ow; }
                    ssum += __shfl_xor(ssum, 16); ssum += __shfl_xor(ssum, 32);
                    if (fq == 0) atomicAdd(rss_out + row, (unsigned long long)__float2ll_rn(ssum * 1048576.f)); }
              }
            }
        }
    }
};

template <class Epi, class Sched, bool ALIGN_EPI = false, bool SP2 = false>
__device__ __forceinline__ void gemm_phase(PG8_LAS unsigned char* lds, const Gemm g, const Sched& S, const Epi& E) {
    const int tid = threadIdx.x, wid = __builtin_amdgcn_readfirstlane(tid >> 6), lane = tid & 63, wr = wid >> 2, wc = wid & 3, fr = lane & 15, fq = lane >> 4;
    const int K = g.K, nt = K / BK;
    unsigned voffA[2], voffB[2];
#pragma unroll
    for (int i = 0; i < 2; ++i) { int R, C; stage_rc(tid * 16 + i * 8192, R, C); const int Rb = E.perm ? ((R & ~31) + perm32(R & 31)) : R;
        voffA[i] = (unsigned)(R * K + C) * 2u; voffB[i] = (unsigned)(Rb * K + C) * 2u; }
    const size_t kstep = (size_t)(BK * 2);
    const size_t hstep = (size_t)HALF * K * 2;
    const size_t tstep = 2 * hstep;
    const unsigned ldsw = (unsigned)wid * 1024u;
    const int aoff = lds_byte(wr * 64 + fr, fq * 8), boff = lds_byte(wc * 32 + fr, fq * 8);
#define PG8_SA(b, h) (((b) * 2 + (h)) * HTB)
#define PG8_SB(b, h) ((4 + (b) * 2 + (h)) * HTB)
#define PG8_STAGE(bufoff, gbase, voff) do { _Pragma("unroll") for (int _i = 0; _i < 2; ++_i) \
        __builtin_amdgcn_global_load_lds((const unsigned*)((const char*)(gbase) + (voff)[_i]), (PG8_LAS unsigned*)(lds + (bufoff) + ldsw + _i * 8192), 16, 0, 0); } while (0)
#define PG8_LDA(dst, b, h) do { _Pragma("unroll") for (int m = 0; m < 4; ++m) _Pragma("unroll") for (int k = 0; k < 2; ++k) dst[m][k] = *(const PG8_LAS bf16x8*)(lds + PG8_SA(b, h) + aoff + m * 2048 + k * 1024); } while (0)
#define PG8_LDB(dst, b, h) do { _Pragma("unroll") for (int n = 0; n < 2; ++n) _Pragma("unroll") for (int k = 0; k < 2; ++k) dst[n][k] = *(const PG8_LAS bf16x8*)(lds + PG8_SB(b, h) + boff + n * 2048 + k * 1024); } while (0)
#define PG8_MMA(ai, bj, At, Bt) do { __builtin_amdgcn_s_setprio(1); _Pragma("unroll") for (int m = 0; m < 4; ++m) _Pragma("unroll") for (int n = 0; n < 2; ++n) _Pragma("unroll") for (int k = 0; k < 2; ++k) \
        acc[ai][bj][m][n] = __builtin_amdgcn_mfma_f32_16x16x32_bf16(Bt[n][k], At[m][k], acc[ai][bj][m][n], 0, 0, 0); __builtin_amdgcn_s_setprio(0); } while (0)
#define PG8_WAIT_V(n) asm volatile("s_waitcnt vmcnt(" #n ")" ::: "memory")
#define PG8_WAIT_L(n) asm volatile("s_waitcnt lgkmcnt(" #n ")" ::: "memory")
#define PG8_BAR __builtin_amdgcn_s_barrier()
#define PG8_SCHED __builtin_amdgcn_sched_barrier(0)
    Unit cur, nxt; int ui = 0;
    if (!S.next(0, cur)) return;
    f32x4 acc[2][2][4][2];
#pragma unroll
    for (int a = 0; a < 2; ++a)
#pragma unroll
        for (int b = 0; b < 2; ++b)
#pragma unroll
            for (int m = 0; m < 4; ++m)
#pragma unroll
                for (int n = 0; n < 2; ++n) acc[a][b][m][n] = (f32x4){0.f, 0.f, 0.f, 0.f};
    bf16x8 At[4][2], B0[2][2], B1[2][2];
    const char* cA = (const char*)g.A + (size_t)cur.pm * tstep; const char* cB = (const char*)g.Bt + (size_t)cur.pn * tstep;
    S.a_ready(cur);
    if constexpr (SP2) {
        PG8_STAGE(PG8_SB(0, 0), cB, voffB); PG8_STAGE(PG8_SB(0, 1), cB + hstep, voffB); PG8_STAGE(PG8_SA(0, 0), cA, voffA); PG8_STAGE(PG8_SA(0, 1), cA + hstep, voffA);
        if (wr == 1) PG8_BAR;
        PG8_WAIT_V(2); PG8_BAR;
        PG8_STAGE(PG8_SB(1, 0), cB + kstep, voffB); PG8_STAGE(PG8_SA(1, 0), cA + kstep, voffA); PG8_STAGE(PG8_SB(1, 1), cB + hstep + kstep, voffB);
        PG8_WAIT_V(6); PG8_BAR;
    } else {
        PG8_STAGE(PG8_SB(0, 0), cB, voffB); PG8_STAGE(PG8_SA(0, 0), cA, voffA); PG8_STAGE(PG8_SB(0, 1), cB + hstep, voffB); PG8_STAGE(PG8_SA(0, 1), cA + hstep, voffA);
        if (wr == 1) PG8_BAR;
        PG8_WAIT_V(4); PG8_BAR;
        PG8_STAGE(PG8_SB(1, 0), cB + kstep, voffB); PG8_STAGE(PG8_SA(1, 0), cA + kstep, voffA); PG8_STAGE(PG8_SB(1, 1), cB + hstep + kstep, voffB);
        PG8_WAIT_V(6); PG8_BAR;
    }
    for (;;) {
        const bool has_next = S.next(ui + 1, nxt);
        const char* nA = has_next ? (const char*)g.A + (size_t)nxt.pm * tstep : cA; const char* nB = has_next ? (const char*)g.Bt + (size_t)nxt.pn * tstep : cB;
        for (int t = 0; t < nt; t += 2) {
            const bool last = (t == nt - 2);
            const char* a1 = cA + (size_t)(t + 1) * kstep;
            const char* a2 = last ? nA : cA + (size_t)(t + 2) * kstep; const char* b2 = last ? nB : cB + (size_t)(t + 2) * kstep;
            const char* a3 = a2 + kstep; const char* b3 = b2 + kstep;
            if (last && has_next) S.a_ready(nxt);
            if constexpr (SP2) {
            PG8_LDB(B0, 0, 0); PG8_LDB(B1, 0, 1); PG8_SCHED; PG8_LDA(At, 0, 0); PG8_STAGE(PG8_SA(1, 1), a1 + hstep, voffA);
            PG8_WAIT_V(8); PG8_WAIT_L(0); PG8_BAR; PG8_MMA(0, 0, At, B0); PG8_MMA(0, 1, At, B1); PG8_BAR; PG8_SCHED;
            PG8_LDA(At, 0, 1); PG8_STAGE(PG8_SB(0, 0), b2, voffB); PG8_STAGE(PG8_SB(0, 1), b2 + hstep, voffB); PG8_STAGE(PG8_SA(0, 0), a2, voffA);
            PG8_WAIT_V(8); PG8_WAIT_L(0); PG8_BAR; PG8_MMA(1, 0, At, B0); PG8_MMA(1, 1, At, B1); PG8_BAR; PG8_SCHED;
            PG8_LDB(B0, 1, 0); PG8_LDB(B1, 1, 1); PG8_SCHED; PG8_LDA(At, 1, 0); PG8_STAGE(PG8_SA(0, 1), a2 + hstep, voffA);
            PG8_WAIT_V(8); PG8_WAIT_L(0); PG8_BAR; PG8_MMA(0, 0, At, B0); PG8_MMA(0, 1, At, B1); PG8_BAR; PG8_SCHED;
            PG8_LDA(At, 1, 1); PG8_STAGE(PG8_SB(1, 0), b3, voffB); PG8_STAGE(PG8_SB(1, 1), b3 + hstep, voffB); PG8_STAGE(PG8_SA(1, 0), a3, voffA);
            PG8_WAIT_V(8); PG8_WAIT_L(0); PG8_BAR; PG8_MMA(1, 0, At, B0); PG8_MMA(1, 1, At, B1); PG8_BAR; PG8_SCHED;
            } else {
            PG8_LDB(B0, 0, 0); PG8_SCHED; PG8_LDA(At, 0, 0); PG8_STAGE(PG8_SA(1, 1), a1 + hstep, voffA);
            PG8_WAIT_L(8); PG8_BAR; PG8_WAIT_L(0); PG8_MMA(0, 0, At, B0); PG8_BAR; PG8_SCHED;
            PG8_LDB(B1, 0, 1); PG8_STAGE(PG8_SB(0, 0), b2, voffB);
            PG8_BAR; PG8_WAIT_L(0); PG8_MMA(0, 1, At, B1); PG8_BAR;
            PG8_LDA(At, 0, 1); PG8_STAGE(PG8_SA(0, 0), a2, voffA);
            PG8_BAR; PG8_WAIT_L(0); PG8_MMA(1, 0, At, B0); PG8_BAR; PG8_SCHED;
            PG8_STAGE(PG8_SB(0, 1), b2 + hstep, voffB);
            PG8_WAIT_V(6); PG8_BAR; PG8_MMA(1, 1, At, B1); PG8_BAR;
            PG8_LDB(B0, 1, 0); PG8_SCHED; PG8_LDA(At, 1, 0); PG8_STAGE(PG8_SA(0, 1), a2 + hstep, voffA);
            PG8_WAIT_L(8); PG8_BAR; PG8_WAIT_L(0); PG8_MMA(0, 0, At, B0); PG8_BAR; PG8_SCHED;
            PG8_LDB(B1, 1, 1); PG8_STAGE(PG8_SB(1, 0), b3, voffB);
            PG8_BAR; PG8_WAIT_L(0); PG8_MMA(0, 1, At, B1); PG8_BAR;
            PG8_LDA(At, 1, 1); PG8_STAGE(PG8_SA(1, 0), a3, voffA);
            PG8_BAR; PG8_WAIT_L(0); PG8_MMA(1, 0, At, B0); PG8_BAR; PG8_SCHED;
            PG8_STAGE(PG8_SB(1, 1), b3 + hstep, voffB);
            PG8_WAIT_V(6); PG8_BAR; PG8_MMA(1, 1, At, B1); PG8_BAR;
            }
        }
        if constexpr (ALIGN_EPI) { if (wr == 0) PG8_BAR; }
        if constexpr (!Epi::AFTER_DRAIN) { E(acc, cur, wr, wc, fr, fq); S.done(cur); }
        if (!has_next) break;
#pragma unroll
        for (int a = 0; a < 2; ++a)
#pragma unroll
            for (int b = 0; b < 2; ++b)
#pragma unroll
                for (int m = 0; m < 4; ++m)
#pragma unroll
                    for (int n = 0; n < 2; ++n) acc[a][b][m][n] = (f32x4){0.f, 0.f, 0.f, 0.f};
        cur = nxt; cA = nA; cB = nB; ++ui;
        if constexpr (ALIGN_EPI) { if (wr == 1) PG8_BAR; }
    }
    PG8_WAIT_V(0);
    if constexpr (!ALIGN_EPI) { if (wr == 0) PG8_BAR; }
    PG8_BAR;
    if constexpr (Epi::AFTER_DRAIN) { E.fused(acc, cur, wr, wc, fr, fq, lds, wid, lane); S.done(cur); }
#undef PG8_SA
#undef PG8_SB
#undef PG8_STAGE
#undef PG8_LDA
#undef PG8_LDB
#undef PG8_MMA
#undef PG8_WAIT_V
#undef PG8_WAIT_L
#undef PG8_BAR
#undef PG8_SCHED
}
}
#define LAS __attribute__((address_space(3)))
typedef unsigned short bf16_t;
typedef float f32x4 __attribute__((ext_vector_type(4)));
typedef unsigned u32x4 __attribute__((ext_vector_type(4)));
typedef unsigned u32x2 __attribute__((ext_vector_type(2)));
typedef short bf16x8s __attribute__((ext_vector_type(8)));
typedef float f32x16 __attribute__((ext_vector_type(16)));
#define MFMA32(a_, b_, c_) __builtin_amdgcn_mfma_f32_32x32x16_bf16((a_), (b_), (c_), 0, 0, 0)
constexpr int SEQ = 16384, TT = 32768, DM = 1024, INW = 3840, DFF = 4096, PLE = 256, DEPTH = 4;
constexpr int C_RQ = 0, C_RK = 512, C_RV = 1024, C_RG = 1536, C_SQ = 2048, C_SK = 2304, C_SV = 2560, C_Z = 2816;
constexpr size_t MiB = 1048576;
constexpr size_t WS_CTL = 0, WS_LORA = 65536, WS_ROPE = 1 * MiB, WS_WB = 5 * MiB, WS_NB = 33 * MiB, WS_PJ = 97 * MiB, WS_MX = 353 * MiB, WS_KV = 417 * MiB, WS_RWX = 449 * MiB, WS_VT = 481 * MiB, WS_HP = 497 * MiB, WS_SC = WS_WB  , WS_RSS = 507 * MiB, WS_END = 511 * MiB;
constexpr size_t WB_IN = 0, WB_O = WB_IN + (size_t)INW * DM, WB_1 = WB_O + (size_t)DM * DM, WB_2 = WB_1 + (size_t)DFF * DM, WB_PG = WB_2 + (size_t)DM * DFF, WB_PE = WB_PG + (size_t)DM * DM;
constexpr int LDS_BYTES = 147456;
constexpr int NPHASE = 46, NSUB = 11;

struct Args { const float* in[24]; float* out; unsigned char* ws; int ph_lo, ph_hi; };
typedef const __attribute__((address_space(4))) Args& ArgsR;
#define PH_FN __device__ __forceinline__

__device__ __forceinline__ int ltid() { int t = threadIdx.x; asm volatile("" : "+v"(t)); return t; }
__device__ __forceinline__ float bf2f(bf16_t v) { return __uint_as_float((unsigned)v << 16); }
__device__ __forceinline__ float bflo(unsigned w) { return __uint_as_float(w << 16); }
__device__ __forceinline__ float bfhi(unsigned w) { return __uint_as_float(w & 0xffff0000u); }
typedef __bf16 hbf16x2 __attribute__((ext_vector_type(2)));
typedef float hf32x2 __attribute__((ext_vector_type(2)));
__device__ __forceinline__ unsigned pk2(float lo, float hi) { const hf32x2 f = {lo, hi}; return __builtin_bit_cast(unsigned, __builtin_convertvector(f, hbf16x2)); }
__device__ __forceinline__ unsigned f2bf(float f) { return pk2(f, 0.f) & 0xffffu; }
__device__ __forceinline__ float wave_sum(float v) {
#pragma unroll
    for (int o = 1; o < 64; o <<= 1) v += __shfl_xor(v, o);
    return v;
}
template <int CTRL> __device__ __forceinline__ float dpp_mov(float x) { return __int_as_float(__builtin_amdgcn_update_dpp(0, __float_as_int(x), CTRL, 0xf, 0xf, false)); }
__device__ __forceinline__ float allred16(float x) { x += dpp_mov<0x128>(x); x += dpp_mov<0x124>(x); x += dpp_mov<0x122>(x); x += dpp_mov<0x121>(x); return x; }
__device__ __forceinline__ float allred4(float x) { x += dpp_mov<0xB1>(x); x += dpp_mov<0x4E>(x); return x; }
__device__ __forceinline__ float sigmoidf_(float x) { return 1.f / (1.f + __expf(-x)); }
__device__ __forceinline__ float softplusf_(float x) { return fmaxf(x, 0.f) + __logf(1.f + __expf(-fabsf(x))); }
__device__ __forceinline__ float ret_logg(int h) { return logf(1.f - exp2f(-5.f - (float)h)); }

PH_FN void ph_prologue(ArgsR a) {
    { unsigned long long* rss = (unsigned long long*)(a.ws + WS_RSS);
        for (int i = blockIdx.x * 512 + ltid(); i < 12 * TT; i += gridDim.x * 512) rss[TT + i] = 0ull;
        const int lane = ltid() & 63, wave = ltid() >> 6; bf16_t* H = (bf16_t*)(a.ws + WS_MX);
        for (int m = blockIdx.x * 8 + wave; m < TT; m += gridDim.x * 16) { const int m2 = m + gridDim.x * 8;
            const f32x4* xr = (const f32x4*)(a.in[0] + (size_t)m * DM) + lane; const f32x4* xr2 = (const f32x4*)(a.in[0] + (size_t)(m2 < TT ? m2 : m) * DM) + lane; f32x4 va[4], vb[4];
#pragma unroll
            for (int j = 0; j < 4; ++j) { va[j] = xr[64 * j]; vb[j] = xr2[64 * j]; }
            float s = 0.f, s2 = 0.f;
#pragma unroll
            for (int j = 0; j < 4; ++j) { const f32x4 v = va[j]; s += (v.x * v.x + v.y * v.y) + (v.z * v.z + v.w * v.w); u32x2 w; w.x = pk2(v.x, v.y); w.y = pk2(v.z, v.w); ((u32x2*)(H + (size_t)m * DM))[lane + 64 * j] = w; }
            if (m2 < TT) {
#pragma unroll
                for (int j = 0; j < 4; ++j) { const f32x4 v = vb[j]; s2 += (v.x * v.x + v.y * v.y) + (v.z * v.z + v.w * v.w); u32x2 w; w.x = pk2(v.x, v.y); w.y = pk2(v.z, v.w); ((u32x2*)(H + (size_t)m2 * DM))[lane + 64 * j] = w; }
                s2 = wave_sum(s2); if (lane == 0) rss[m2] = (unsigned long long)__float2ll_rn(s2 * 1048576.f); }
            s = wave_sum(s); if (lane == 0) rss[m] = (unsigned long long)__float2ll_rn(s * 1048576.f); } }
    float* cosT = (float*)(a.ws + WS_ROPE); float* sinT = cosT + SEQ * 32;
    for (int idx = blockIdx.x * 512 + ltid(); idx < SEQ * 32; idx += gridDim.x * 512) {
        const int pos = idx >> 5, i = idx & 31;
        double inv = 1.0, f = 0.7429639507594948;
#pragma unroll
        for (int bit = 0; bit < 5; ++bit) { if ((i >> bit) & 1) inv *= f; f *= f; }
        const double ang = (double)pos * inv;
        const double n = rint(ang * 0.15915494309189535);
        const float r = (float)(ang - n * 6.283185307179586);
        cosT[idx] = __cosf(r); sinT[idx] = __sinf(r);
    }
}
__device__ __forceinline__ void transpose_item(const float* W, int K, int N, bf16_t* WT, LAS float* scr, int item, int lane, const float* g = nullptr) {
    const int nblk = N / 32, kb = item / nblk, nb = item % nblk, k0 = 64 * kb, n0 = 32 * nb;
    float tv[32];
#pragma unroll
    for (int i = 0; i < 32; ++i) { const int kk = 2 * i + (lane >> 5); tv[i] = W[(size_t)(k0 + kk) * N + n0 + (lane & 31)]; }
#pragma unroll
    for (int i = 0; i < 32; ++i) { const int kk = 2 * i + (lane >> 5); scr[kk * 33 + (lane & 31)] = tv[i] * (g ? g[k0 + kk] : 1.f); }
    asm volatile("s_waitcnt lgkmcnt(0)" ::: "memory");
    const int c = lane & 7;
#pragma unroll
    for (int j = 0; j < 4; ++j) { const int n = (lane >> 3) + 8 * j; const LAS float* s = scr + (8 * c) * 33 + n;
        u32x4 o; o.x = pk2(s[0 * 33], s[1 * 33]); o.y = pk2(s[2 * 33], s[3 * 33]); o.z = pk2(s[4 * 33], s[5 * 33]); o.w = pk2(s[6 * 33], s[7 * 33]);
        *(u32x4*)(WT + (size_t)(n0 + n) * K + k0 + 8 * c) = o; }
    asm volatile("s_waitcnt lgkmcnt(0)" ::: "memory");
}
PH_FN void ph_weights(ArgsR a, int L, LAS unsigned char* lds) {
    const int lane = ltid() & 63, wave = ltid() >> 6;
    LAS float* scr = (LAS float*)(lds + wave * 16384);
    bf16_t* WB = (bf16_t*)(a.ws + WS_WB);
    const int gw = blockIdx.x * 8 + wave, NGW = gridDim.x * 8;
    constexpr int I_IN = (DM / 64) * (INW / 32), I_O = (DM / 64) * (DM / 32), I_1 = (DM / 64) * (DFF / 32), I_2 = (DFF / 64) * (DM / 32), I_PG = I_O, I_PE = (PLE / 64) * (DM / 32);
    constexpr int NITEMS = I_IN + I_O + I_1 + I_2 + I_PG + I_PE;
    for (int it = gw; it < NITEMS; it += NGW) {
        int r = it;
        if (r < I_IN) { transpose_item(a.in[5] + (size_t)L * DM * INW, DM, INW, WB + WB_IN, scr, r, lane, a.in[2] + L * DM); continue; } r -= I_IN;
        if (r < I_O) { transpose_item(a.in[18] + (size_t)L * DM * DM, DM, DM, WB + WB_O, scr, r, lane); continue; } r -= I_O;
        if (r < I_1) { transpose_item(a.in[19] + (size_t)L * DM * DFF, DM, DFF, WB + WB_1, scr, r, lane, a.in[3] + L * DM); continue; } r -= I_1;
        if (r < I_2) { transpose_item(a.in[20] + (size_t)L * DFF * DM, DFF, DM, WB + WB_2, scr, r, lane); continue; } r -= I_2;
        if (r < I_PG) { transpose_item(a.in[22] + (size_t)L * DM * DM, DM, DM, WB + WB_PG, scr, r, lane, a.in[4] + L * DM); continue; } r -= I_PG;
        transpose_item(a.in[21] + (size_t)L * PLE * DM, PLE, DM, WB + WB_PE, scr, r, lane);
    }
    { bf16_t* LW = (bf16_t*)(a.ws + WS_LORA);
        for (int it = gw; it < 32; it += NGW) {
            if (it < 8) transpose_item(a.in[9] + (size_t)L * 64 * 256, 64, 256, LW, scr, it, lane);
            else if (it < 16) transpose_item(a.in[11] + (size_t)L * 64 * 256, 64, 256, LW + 256 * 64, scr, it - 8, lane);
            else transpose_item(a.in[12] + (size_t)L * 128 * 256, 128, 256, LW + 2 * 256 * 64, scr, it - 16, lane); } }
}
PH_FN void ph_final(const unsigned long long* rss, const float* g, float* dst) {
    const int lane = ltid() & 63, wave = ltid() >> 6;
    f32x4 gg[4];
#pragma unroll
    for (int j = 0; j < 4; ++j) gg[j] = ((const f32x4*)g)[lane + 64 * j];
    for (int m = blockIdx.x * 8 + wave; m < TT; m += gridDim.x * 16) { const int m2 = (m + gridDim.x * 8 < TT) ? m + gridDim.x * 8 : m;
        const float rs = rsqrtf((float)rss[m] * (1.f / (1024.f * 1048576.f)) + 1e-6f), rs2 = rsqrtf((float)rss[m2] * (1.f / (1024.f * 1048576.f)) + 1e-6f);
        f32x4* row = (f32x4*)(dst + (size_t)m * DM); f32x4* row2 = (f32x4*)(dst + (size_t)m2 * DM); f32x4 va[4], vb[4];
#pragma unroll
        for (int j = 0; j < 4; ++j) { va[j] = row[lane + 64 * j]; vb[j] = row2[lane + 64 * j]; }
#pragma unroll
        for (int j = 0; j < 4; ++j) row[lane + 64 * j] = va[j] * rs * gg[j];
        if (m2 != m) {
#pragma unroll
            for (int j = 0; j < 4; ++j) row2[lane + 64 * j] = vb[j] * rs2 * gg[j]; } }
}
PH_FN void ph_pconv(const float* p, bf16_t* dst) {
    const size_t n4 = (size_t)TT * PLE / 4, stride = (size_t)gridDim.x * 512;
    size_t i = (size_t)blockIdx.x * 512 + ltid();
    for (; i + 7 * stride < n4; i += 8 * stride) { f32x4 v[8];
#pragma unroll
        for (int q = 0; q < 8; ++q) v[q] = ((const f32x4*)p)[i + q * stride];
#pragma unroll
        for (int q = 0; q < 8; ++q) { u32x2 w; w.x = pk2(v[q].x, v[q].y); w.y = pk2(v[q].z, v[q].w); ((u32x2*)dst)[i + q * stride] = w; } }
    for (; i < n4; i += stride) { const f32x4 v = ((const f32x4*)p)[i]; u32x2 w; w.x = pk2(v.x, v.y); w.y = pk2(v.z, v.w); ((u32x2*)dst)[i] = w; }
}
__device__ __forceinline__ f32x4 bf4(u32x2 w) { return (f32x4){bflo(w.x), bfhi(w.x), bflo(w.y), bfhi(w.y)}; }
PH_FN void ph_rwkv_prep(ArgsR a, int L, LAS unsigned char* lds) {
    constexpr int ZB_LD = 264, OB_LD = 776;
    LAS bf16_t* zb = (LAS bf16_t*)lds;
    LAS bf16_t* ob = zb + 64 * ZB_LD;
    LAS float* zl = (LAS float*)(ob + 64 * OB_LD);
    const int tid = ltid(), lane = tid & 63, wave = tid >> 6, cq = tid & 63, tg = tid >> 6, c4 = 4 * cq;
    const bf16_t* PJ = (const bf16_t*)(a.ws + WS_PJ);
    bf16_t* RW_R = (bf16_t*)(a.ws + WS_NB); bf16_t* RW_KM = RW_R + (size_t)TT * 256; bf16_t* RW_V = RW_KM + (size_t)TT * 256; bf16_t* RW_KK = RW_V + (size_t)TT * 256;
    bf16_t* RW_LD = (bf16_t*)(a.ws + WS_RWX); bf16_t* RW_B = (bf16_t*)(a.ws + WS_RWX + 16 * MiB); bf16_t* RW_G = (bf16_t*)(a.ws + WS_PJ + 240 * MiB); bf16_t* VT = (bf16_t*)(a.ws + WS_VT);
    unsigned* kmax = (unsigned*)(a.ws + WS_CTL) + 64 + L * 8;
    const float* mu = a.in[7] + L * 1024; const float* w0 = a.in[8] + L * 256; const float* w_up = a.in[9] + L * 64 * 256; const float* a0 = a.in[10] + L * 256;
    const float* a_up = a.in[11] + L * 64 * 256; const float* g_up = a.in[12] + L * 128 * 256; const float* k_k = a.in[13] + L * 256; const float* k_a = a.in[14] + L * 256;
    float mxl0 = 0.f, mxl1 = 0.f;
    for (int u = blockIdx.x; u < TT / 64; u += gridDim.x) {
        const int tok0 = u * 64;
        for (int v8 = tid; v8 < 64 * 32; v8 += 512) { const int t = v8 >> 5, c8 = (v8 & 31) * 8, tok = tok0 + t;
            const u32x4 zc = *(const u32x4*)(PJ + (size_t)tok * INW + C_Z + 768 + c8);
            u32x4 zp = (u32x4){0u, 0u, 0u, 0u}; if ((tok & (SEQ - 1)) != 0) zp = *(const u32x4*)(PJ + (size_t)(tok - 1) * INW + C_Z + 768 + c8);
            const float zv[8] = {bflo(zc.x), bfhi(zc.x), bflo(zc.y), bfhi(zc.y), bflo(zc.z), bfhi(zc.z), bflo(zc.w), bfhi(zc.w)};
            const float pv[8] = {bflo(zp.x), bfhi(zp.x), bflo(zp.y), bfhi(zp.y), bflo(zp.z), bfhi(zp.z), bflo(zp.w), bfhi(zp.w)};
            const f32x4 m0 = *(const f32x4*)(mu + 768 + c8), m1 = *(const f32x4*)(mu + 768 + c8 + 4); const float mv[8] = {m0.x, m0.y, m0.z, m0.w, m1.x, m1.y, m1.z, m1.w};
            float o[8];
#pragma unroll
            for (int q = 0; q < 8; ++q) { float val = zv[q] + mv[q] * (pv[q] - zv[q]);
                if (c8 < 64) val = 1.f - 2.f / (1.f + __expf(2.f * val)); else if (c8 >= 128) val = sigmoidf_(val);
                o[q] = val; }
            *(LAS u32x4*)(zb + t * ZB_LD + c8) = (u32x4){pk2(o[0], o[1]), pk2(o[2], o[3]), pk2(o[4], o[5]), pk2(o[6], o[7])}; }
        asm volatile("" ::: "memory");
        __syncthreads();
        { const int r_ = lane & 31, hh_ = lane >> 5; const bf16_t* LW = (const bf16_t*)(a.ws + WS_LORA);
#pragma unroll
            for (int pr = 0; pr < 3; ++pr) {
                const int nk = (pr == 2) ? 8 : 4, zo = (pr == 0) ? 0 : (pr == 1) ? 64 : 128; const bf16_t* wp = LW + (pr == 0 ? 0 : pr == 1 ? 256 * 64 : 2 * 256 * 64) + (size_t)(32 * wave + r_) * (16 * nk) + 8 * hh_;
                bf16x8s bfr[8];
#pragma unroll
                for (int ks = 0; ks < 8; ++ks) if (ks < nk) bfr[ks] = __builtin_bit_cast(bf16x8s, *(const u32x4*)(wp + 16 * ks));
#pragma unroll
                for (int tb = 0; tb < 2; ++tb) { f32x16 x;
#pragma unroll
                    for (int i = 0; i < 16; ++i) x[i] = 0.f;
                    const LAS bf16_t* ar = zb + (32 * tb + r_) * ZB_LD + 8 * hh_ + zo;
#pragma unroll
                    for (int ks = 0; ks < 8; ++ks) if (ks < nk) x = MFMA32(__builtin_bit_cast(bf16x8s, *(const LAS u32x4*)(ar + 16 * ks)), bfr[ks], x);
#pragma unroll
                    for (int i = 0; i < 16; ++i) ob[(32 * tb + (i & 3) + 8 * (i >> 2) + 4 * hh_) * OB_LD + 256 * pr + 32 * wave + r_] = (bf16_t)f2bf(x[i]); } } }
        asm volatile("" ::: "memory");
        __syncthreads();
        const f32x4 w0v = *(const f32x4*)(w0 + c4), a0v = *(const f32x4*)(a0 + c4);
        { const f32x4 kkc = *(const f32x4*)(k_k + c4), kac = *(const f32x4*)(k_a + c4), mr = *(const f32x4*)(mu + c4), mk = *(const f32x4*)(mu + 256 + c4), mvv = *(const f32x4*)(mu + 512 + c4);
#pragma unroll 1
            for (int tb4 = 0; tb4 < 2; ++tb4) {
              u32x2 lr[4], lk[4], lv[4], lrp[4], lkp[4], lvp[4];
#pragma unroll
              for (int t4 = 0; t4 < 4; ++t4) { const int tok = tok0 + 8 * tg + 4 * tb4 + t4; const bf16_t* zr = PJ + (size_t)tok * INW + C_Z + c4; const bool first = (tok & (SEQ - 1)) == 0;
                lr[t4] = *(const u32x2*)(zr); lk[t4] = *(const u32x2*)(zr + 256); lv[t4] = *(const u32x2*)(zr + 512);
                lrp[t4] = (u32x2){0u, 0u}; lkp[t4] = lrp[t4]; lvp[t4] = lrp[t4];
                if (!first) { lrp[t4] = *(const u32x2*)(zr - INW); lkp[t4] = *(const u32x2*)(zr - INW + 256); lvp[t4] = *(const u32x2*)(zr - INW + 512); } }
#pragma unroll
              for (int t4 = 0; t4 < 4; ++t4) { const int t = 4 * tb4 + t4; const int tok = tok0 + 8 * tg + t; const size_t idx = (size_t)tok * 256 + c4;
                const f32x4 rc = bf4(lr[t4]), kc = bf4(lk[t4]), vc = bf4(lv[t4]), rp = bf4(lrp[t4]), kp = bf4(lkp[t4]), vp = bf4(lvp[t4]);
                const f32x4 r = rc + mr * (rp - rc), k = kc + mk * (kp - kc), v = vc + mvv * (vp - vc);
                f32x4 ld, as, kk, km, bb;
                const LAS bf16_t* orow = ob + (8 * tg + t) * OB_LD + c4; const f32x4 lwv = bf4(*(const LAS u32x2*)orow) + w0v, aav = bf4(*(const LAS u32x2*)(orow + 256)) + a0v, ggv = bf4(*(const LAS u32x2*)(orow + 512));
#pragma unroll
                for (int q = 0; q < 4; ++q) { const float logw = -softplusf_(-lwv[q]) - 0.5f; ld[q] = -__expf(logw); as[q] = sigmoidf_(aav[q]); }
                kk = k * kkc; const float n2 = allred16((kk.x * kk.x + kk.y * kk.y) + (kk.z * kk.z + kk.w * kk.w)); kk = kk * (1.f / fmaxf(sqrtf(n2), 1e-12f));
                km = k * (1.f + (as - 1.f) * kac); bb = kk * as;
                *(u32x2*)(RW_R + idx) = (u32x2){pk2(r.x, r.y), pk2(r.z, r.w)}; *(u32x2*)(RW_KM + idx) = (u32x2){pk2(km.x, km.y), pk2(km.z, km.w)}; *(u32x2*)(RW_V + idx) = (u32x2){pk2(v.x, v.y), pk2(v.z, v.w)};
                *(u32x2*)(RW_KK + idx) = (u32x2){pk2(kk.x, kk.y), pk2(kk.z, kk.w)}; *(u32x2*)(RW_B + idx) = (u32x2){pk2(bb.x, bb.y), pk2(bb.z, bb.w)}; *(u32x2*)(RW_LD + idx) = (u32x2){pk2(ld.x, ld.y), pk2(ld.z, ld.w)};
                *(u32x2*)(RW_G + idx) = (u32x2){pk2(ggv.x, ggv.y), pk2(ggv.z, ggv.w)}; } } }
        { const int b = tok0 / SEQ; float n2m = 0.f;
#pragma unroll
            for (int tt = 0; tt < 8; ++tt) { const f32x4 kv = bf4(*(const u32x2*)(PJ + (size_t)(tok0 + 8 * wave + tt) * INW + C_SK + 4 * lane));
                n2m = fmaxf(n2m, allred16((kv.x * kv.x + kv.y * kv.y) + (kv.z * kv.z + kv.w * kv.w))); }
            if (b == 0) mxl0 = fmaxf(mxl0, n2m); else mxl1 = fmaxf(mxl1, n2m); }
        { const int col = tid & 255, b = tok0 / SEQ; unsigned short e[4][8];
#pragma unroll
            for (int it = 0; it < 4; ++it) { const int th = (tid >> 8) + 2 * it;
#pragma unroll
                for (int t = 0; t < 8; ++t) e[it][t] = PJ[(size_t)(tok0 + th * 8 + t) * INW + C_SV + col]; }
#pragma unroll
            for (int it = 0; it < 4; ++it) { const int th = (tid >> 8) + 2 * it, s0 = (tok0 & (SEQ - 1)) + th * 8;
                u32x4 o; o.x = e[it][0] | ((unsigned)e[it][1] << 16); o.y = e[it][2] | ((unsigned)e[it][3] << 16); o.z = e[it][4] | ((unsigned)e[it][5] << 16); o.w = e[it][6] | ((unsigned)e[it][7] << 16);
                *(u32x4*)(VT + ((size_t)((b * 4 + (col >> 6)) * 64 + (col & 63))) * SEQ + s0) = o; } }
        __syncthreads();
    }
    if ((lane & 15) == 0) { zl[wave * 8 + (lane >> 4)] = mxl0; zl[wave * 8 + 4 + (lane >> 4)] = mxl1; }
    __syncthreads();
    if (tid < 8) { float m = 0.f;
#pragma unroll
        for (int w_ = 0; w_ < 8; ++w_) m = fmaxf(m, zl[w_ * 8 + tid]);
        atomicMax(kmax + tid, __float_as_uint(m)); }
    __syncthreads();
}
typedef float f32x2 __attribute__((ext_vector_type(2)));
constexpr int SC_NC = 32, SC_LEN = SEQ / SC_NC;
struct ScOps { f32x4 r, w, km, kk, b, vv; };
template <int NR> __device__ __forceinline__ ScOps sc_ld(const LAS float* p, int j4, int rowA) { ScOps o; o.r = *(const LAS f32x4*)(p + j4); o.w = *(const LAS f32x4*)(p + 64 + j4); o.km = *(const LAS f32x4*)(p + 128 + j4);
    o.kk = *(const LAS f32x4*)(p + 192 + j4); o.b = *(const LAS f32x4*)(p + 256 + j4);
    if (NR == 4) o.vv = *(const LAS f32x4*)(p + 320 + rowA); else { const f32x2 v2 = *(const LAS f32x2*)(p + 320 + rowA); o.vv = (f32x4){v2.x, v2.y, 0.f, 0.f}; } return o; }
template <int NR, bool REAL, bool YOUT> __device__ __forceinline__ void sc_step(const ScOps& o, f32x2 (&S)[4][2], LAS float* yp) {
    const f32x2 kk01 = o.kk.xy, kk23 = o.kk.zw, w01 = o.w.xy, w23 = o.w.zw, bb01 = o.b.xy, bb23 = o.b.zw, km01 = o.km.xy, km23 = o.km.zw;
    float sa[4];
#pragma unroll
    for (int c = 0; c < NR; ++c) { const f32x2 pa = S[c][0] * kk01 + S[c][1] * kk23; sa[c] = -allred16(pa.x + pa.y); }
#pragma unroll
    for (int c = 0; c < NR; ++c) { f32x2 t01 = bb01 * sa[c], t23 = bb23 * sa[c];
        if (REAL) { t01 += km01 * o.vv[c]; t23 += km23 * o.vv[c]; }
        S[c][0] = S[c][0] * w01 + t01; S[c][1] = S[c][1] * w23 + t23; }
    if (YOUT) { const f32x2 r01 = o.r.xy, r23 = o.r.zw; f32x4 y = {0.f, 0.f, 0.f, 0.f};
#pragma unroll
        for (int c = 0; c < NR; ++c) { const f32x2 q = S[c][0] * r01 + S[c][1] * r23; y[c] = allred16(q.x + q.y); }
        if (NR == 4) *(LAS f32x4*)yp = y; else *(LAS f32x2*)yp = y.xy; }
}
template <int NR, bool REAL, bool YOUT> __device__ __forceinline__ void sc_chunk(const LAS float* bb, int j4, int rowA, f32x2 (&S)[4][2], LAS float* yb) {
    ScOps oa = sc_ld<NR>(bb, j4, rowA);
#pragma unroll 2
    for (int s = 0; s < 32; s += 2) {
        const ScOps ob = sc_ld<NR>(bb + (s + 1) * 384, j4, rowA);
        sc_step<NR, REAL, YOUT>(oa, S, yb + s * 64 + rowA);
        oa = sc_ld<NR>(bb + (s + 2) * 384, j4, rowA);
        sc_step<NR, REAL, YOUT>(ob, S, yb + (s + 1) * 64 + rowA);
    }
}
template <int PASS> PH_FN void ph_scan_pass(ArgsR a, LAS unsigned char* lds, int unit, int L) {
    const int tid = ltid(), lane = tid & 63, wave = tid >> 6, rg = lane >> 4, j = lane & 15, j4 = 4 * j;
    int bh, c; const int kind = (PASS == 1) ? (wave >> 2) : 0;
    if (PASS == 1) { bh = unit / (SC_NC - 1); c = unit % (SC_NC - 1); } else { bh = unit / SC_NC; c = unit % SC_NC; }
    const int b = bh >> 2, h = bh & 3, t0 = c * SC_LEN;
    constexpr int NR = (PASS == 1) ? 4 : 2;
    const int rowA = (PASS == 1) ? (wave & 3) * 16 + 4 * rg : wave * 8 + 2 * rg;
    const bool active = true;
    const bf16_t* RW_R = (const bf16_t*)(a.ws + WS_NB); const bf16_t* RW_KM = RW_R + (size_t)TT * 256; const bf16_t* RW_V = RW_KM + (size_t)TT * 256; const bf16_t* RW_KK = RW_V + (size_t)TT * 256;
    const bf16_t* RW_LD = (const bf16_t*)(a.ws + WS_RWX); const bf16_t* RW_B = (const bf16_t*)(a.ws + WS_RWX + 16 * MiB);
    float* HP = (float*)(a.ws + WS_HP); const float* SC = (const float*)(a.ws + WS_SC);
    bf16_t* MX = (bf16_t*)(a.ws + WS_MX);
    LAS float* buf0 = (LAS float*)lds; LAS float* ybuf = buf0 + 2 * 32 * 384;
    const int st = tid >> 4, c4 = (tid & 15) * 4;
    const size_t gbase = ((size_t)b * SEQ + t0) * 256 + h * 64 + c4;
    u32x2 pr, pkm, pkk, pb, pv, pw;
#define SC_LOAD(ch) do { const size_t g_ = gbase + (size_t)((ch) * 32 + st) * 256; pr = *(const u32x2*)(RW_R + g_); pkm = *(const u32x2*)(RW_KM + g_); pkk = *(const u32x2*)(RW_KK + g_); \
        pb = *(const u32x2*)(RW_B + g_); pv = *(const u32x2*)(RW_V + g_); pw = *(const u32x2*)(RW_LD + g_); } while (0)
#define SC_UNP(w) ((f32x4){bflo((w).x), bfhi((w).x), bflo((w).y), bfhi((w).y)})
#define SC_STORE(bufi) do { LAS float* d_ = buf0 + (bufi) * (32 * 384) + st * 384 + c4; *(LAS f32x4*)(d_) = SC_UNP(pr); { const f32x4 l_ = SC_UNP(pw); *(LAS f32x4*)(d_ + 64) = (f32x4){__expf(l_.x), __expf(l_.y), __expf(l_.z), __expf(l_.w)}; } *(LAS f32x4*)(d_ + 128) = SC_UNP(pkm); \
        *(LAS f32x4*)(d_ + 192) = SC_UNP(pkk); *(LAS f32x4*)(d_ + 256) = SC_UNP(pb); *(LAS f32x4*)(d_ + 320) = SC_UNP(pv); } while (0)
    const int fs_ = tid >> 4, fr4_ = (tid & 15) * 4; const bf16_t* RW_G = (const bf16_t*)(a.ws + WS_PJ + 240 * MiB);
    f32x4 rk4 = {0.f, 0.f, 0.f, 0.f}, lw4 = rk4, lb4 = rk4; u32x2 fr_ = {0u, 0u}, fkm_ = fr_, fv_ = fr_, fg_ = fr_;
    if (PASS == 2) { rk4 = *(const f32x4*)(a.in[15] + L * 256 + h * 64 + fr4_); lw4 = *(const f32x4*)(a.in[16] + L * 256 + h * 64 + fr4_); lb4 = *(const f32x4*)(a.in[17] + L * 256 + h * 64 + fr4_); }
#define SC_FPRE(chp) do { const size_t i_ = ((size_t)b * SEQ + t0 + (chp) * 32 + fs_) * 256 + h * 64 + fr4_; fr_ = *(const u32x2*)(RW_R + i_); fkm_ = *(const u32x2*)(RW_KM + i_); fv_ = *(const u32x2*)(RW_V + i_); fg_ = *(const u32x2*)(RW_G + i_); } while (0)
#define SC_FLUSH(chp) do { const f32x4 y_ = *(const LAS f32x4*)(ybuf + ((chp) & 1) * 2048 + fs_ * 64 + fr4_); const f32x4 r_ = bf4(fr_), km_ = bf4(fkm_), v_ = bf4(fv_), g_ = bf4(fg_); \
        const float mean_ = allred16((y_.x + y_.y) + (y_.z + y_.w)) * (1.f / 64.f); const f32x4 d_ = y_ - mean_; const float var_ = allred16((d_.x * d_.x + d_.y * d_.y) + (d_.z * d_.z + d_.w * d_.w)) * (1.f / 64.f); \
        const f32x4 t_ = r_ * km_ * rk4; const float bon_ = allred16((t_.x + t_.y) + (t_.z + t_.w)); const f32x4 o_ = (d_ * rsqrtf(var_ + 64e-5f) * lw4 + lb4 + v_ * bon_) * g_; \
        *(u32x2*)(MX + ((size_t)b * SEQ + t0 + (chp) * 32 + fs_) * 1024 + 768 + h * 64 + fr4_) = (u32x2){pk2(o_.x, o_.y), pk2(o_.z, o_.w)}; } while (0)
    f32x2 S[4][2];
#pragma unroll
    for (int q = 0; q < 4; ++q) { S[q][0] = (f32x2){0.f, 0.f}; S[q][1] = (f32x2){0.f, 0.f}; }
    if (PASS == 1) { if (kind == 1) {
#pragma unroll
            for (int q = 0; q < 4; ++q) { S[q][0].x = (j4 == rowA + q) ? 1.f : 0.f; S[q][0].y = (j4 + 1 == rowA + q) ? 1.f : 0.f; S[q][1].x = (j4 + 2 == rowA + q) ? 1.f : 0.f; S[q][1].y = (j4 + 3 == rowA + q) ? 1.f : 0.f; } } }
    else if (c > 0) { const float* sp = SC + ((size_t)(bh * SC_NC + c)) * 4096;
#pragma unroll
        for (int q = 0; q < NR; ++q) { const f32x4 sv = *(const f32x4*)(sp + (rowA + q) * 64 + j4); S[q][0] = sv.xy; S[q][1] = sv.zw; } }
    SC_LOAD(0); SC_STORE(0); __syncthreads();
    constexpr int NRC = SC_LEN / 32;
    for (int ch = 0; ch < NRC; ++ch) {
        if (ch + 1 < NRC) SC_LOAD(ch + 1);
        if (PASS == 2 && ch > 0) SC_FLUSH(ch - 1);
        if (PASS == 2) SC_FPRE(ch);
        const LAS float* bb = buf0 + (ch & 1) * (32 * 384); LAS float* yb = ybuf + (ch & 1) * 2048;
        if (active) {
            if (PASS == 2) sc_chunk<2, true, true>(bb, j4, rowA, S, yb);
            else if (kind == 0) sc_chunk<4, true, false>(bb, j4, rowA, S, yb);
            else sc_chunk<4, false, false>(bb, j4, rowA, S, yb);
        }
        if (ch + 1 < NRC) SC_STORE((ch + 1) & 1);
        __syncthreads();
    }
    if (PASS == 2) SC_FLUSH(NRC - 1);
    else { float* hp = HP + ((size_t)((bh * (SC_NC - 1) + c) * 2 + kind)) * 4096;
#pragma unroll
        for (int q = 0; q < 4; ++q) *(f32x4*)(hp + (rowA + q) * 64 + j4) = (f32x4){S[q][0].x, S[q][0].y, S[q][1].x, S[q][1].y}; }
    __syncthreads();
#undef SC_LOAD
#undef SC_UNP
#undef SC_STORE
#undef SC_FLUSH
#undef SC_FPRE
}
PH_FN void ph_scan_combine(ArgsR a, LAS unsigned char* lds, int unit) {
    LAS float* Ss = (LAS float*)lds; LAS float* Ps = Ss + 16 * 64;
    const float* HP = (const float*)(a.ws + WS_HP); float* SC = (float*)(a.ws + WS_SC);
    const int bh = unit >> 2, v0 = (unit & 3) * 16;
    const int tid = ltid(), v = tid >> 5, k2 = (tid & 31) * 2;
    float s0 = 0.f, s1 = 0.f;
    const float* Hc = HP + ((size_t)(bh * (SC_NC - 1) * 2)) * 4096;
    f32x4 p0 = *(const f32x4*)(Hc + 4096 + tid * 8), p1 = *(const f32x4*)(Hc + 4096 + tid * 8 + 4); f32x2 hv = *(const f32x2*)(Hc + (v0 + v) * 64 + k2);
    for (int c = 0; c < SC_NC - 1; ++c) {
        *(LAS f32x4*)(Ps + tid * 8) = p0; *(LAS f32x4*)(Ps + tid * 8 + 4) = p1; *(LAS f32x2*)(Ss + v * 64 + k2) = (f32x2){s0, s1};
        float n0 = hv.x, n1 = hv.y;
        if (c + 1 < SC_NC - 1) { const float* Hn = Hc + (size_t)(c + 1) * 8192; p0 = *(const f32x4*)(Hn + 4096 + tid * 8); p1 = *(const f32x4*)(Hn + 4096 + tid * 8 + 4); hv = *(const f32x2*)(Hn + (v0 + v) * 64 + k2); }
        __syncthreads();
#pragma unroll 8
        for (int m = 0; m < 64; ++m) { const float sv = Ss[v * 64 + m]; const f32x2 q = *(const LAS f32x2*)(Ps + m * 64 + k2); n0 += sv * q.x; n1 += sv * q.y; }
        s0 = n0; s1 = n1;
        *(f32x2*)(SC + ((size_t)(bh * SC_NC + c + 1)) * 4096 + (v0 + v) * 64 + k2) = (f32x2){s0, s1};
        __syncthreads();
    }
}
PH_FN void ph_ret_scan(ArgsR a, int u) {
    bf16_t* KV = (bf16_t*)(a.ws + WS_KV);
    const int e2 = u * 512 + ltid();
    const int bh = e2 >> 11, within = (e2 & 2047) * 2, h = bh & 7;
    const float g64 = __expf(64.f * ret_logg(h));
    bf16_t* p = KV + (size_t)bh * 256 * 4096 + within;
    float s0 = 0.f, s1 = 0.f;
    for (int c0 = 0; c0 < 256; c0 += 32) { unsigned x[32];
#pragma unroll
        for (int q = 0; q < 32; ++q) x[q] = *(const unsigned*)(p + (size_t)(c0 + q) * 4096);
#pragma unroll
        for (int q = 0; q < 32; ++q) { *(unsigned*)(p + (size_t)(c0 + q) * 4096) = pk2(s0, s1); s0 = s0 * g64 + bflo(x[q]); s1 = s1 * g64 + bfhi(x[q]); } }
}
__device__ __forceinline__ bf16x8s sb_pack8(float w0, float w1, float w2, float w3, float w4, float w5, float w6, float w7) {
    u32x4 pk; pk.x = pk2(w0, w1); pk.y = pk2(w2, w3); pk.z = pk2(w4, w5); pk.w = pk2(w6, w7); return __builtin_bit_cast(bf16x8s, pk); }
__device__ __forceinline__ float sb_pairsum(float x) { const unsigned xi = __float_as_uint(x); const auto rr = __builtin_amdgcn_permlane32_swap(xi, xi, false, false); return __uint_as_float(rr[0]) + __uint_as_float(rr[1]); }
PH_FN void ph_sb(ArgsR a, int L, int first, int nblk) {
    const bf16_t* PJ = (const bf16_t*)(a.ws + WS_PJ); const bf16_t* VT = (const bf16_t*)(a.ws + WS_VT); bf16_t* MX = (bf16_t*)(a.ws + WS_MX);
    const unsigned* kmax = (const unsigned*)(a.ws + WS_CTL) + 64 + L * 8;
    const int tid = ltid(), lane = tid & 63, wave = tid >> 6, r = lane & 31, hh = lane >> 5;
    for (int u = first; u < 512; u += nblk) {
        const int bh = u & 7, qi = (63 - (u >> 3)) * 8 + wave, b = bh >> 2, h = bh & 3, q0 = qi * 32;
        bf16x8s bq[4]; float qn2 = 0.f;
        { const bf16_t* qp = PJ + ((size_t)b * SEQ + q0 + r) * INW + C_SQ + h * 64 + 8 * hh;
#pragma unroll
            for (int ks = 0; ks < 4; ++ks) { const u32x4 w = *(const u32x4*)(qp + 16 * ks); bq[ks] = __builtin_bit_cast(bf16x8s, w);
                qn2 += bflo(w.x) * bflo(w.x) + bfhi(w.x) * bfhi(w.x) + bflo(w.y) * bflo(w.y) + bfhi(w.y) * bfhi(w.y) + bflo(w.z) * bflo(w.z) + bfhi(w.z) * bfhi(w.z) + bflo(w.w) * bflo(w.w) + bfhi(w.w) * bfhi(w.w); } }
        qn2 = sb_pairsum(qn2);
        const float bound = sqrtf(qn2) * 0.125f * sqrtf(__uint_as_float(kmax[bh])) * 1.001f + 1e-3f;
        f32x16 o0, o1;
#pragma unroll
        for (int i = 0; i < 16; ++i) { o0[i] = 0.f; o1[i] = 0.f; }
        float after = 0.f;
        u32x4 nk_[4]; u32x2 nlo[2][2], nhi[2][2];
#define SB_LOADT(k0_) do { const int kc_ = (k0_) >= 0 ? (k0_) : 0; const bf16_t* kp_ = PJ + ((size_t)b * SEQ + kc_ + r) * INW + C_SK + h * 64 + 8 * hh; \
            _Pragma("unroll") for (int ks = 0; ks < 4; ++ks) nk_[ks] = *(const u32x4*)(kp_ + 16 * ks); \
            const bf16_t* vt_ = VT + ((size_t)(bh * 64 + r)) * SEQ + kc_ + 4 * hh; \
            _Pragma("unroll") for (int s = 0; s < 2; ++s) _Pragma("unroll") for (int dh = 0; dh < 2; ++dh) { nlo[s][dh] = *(const u32x2*)(vt_ + (size_t)dh * 32 * SEQ + 16 * s); nhi[s][dh] = *(const u32x2*)(vt_ + (size_t)dh * 32 * SEQ + 16 * s + 8); } } while (0)
        SB_LOADT(q0);
        for (int k0 = q0; k0 >= 0; k0 -= 32) {
            bf16x8s ak[4], pb[2][2];
#pragma unroll
            for (int ks = 0; ks < 4; ++ks) ak[ks] = __builtin_bit_cast(bf16x8s, nk_[ks]);
#pragma unroll
            for (int s = 0; s < 2; ++s)
#pragma unroll
                for (int dh = 0; dh < 2; ++dh) pb[s][dh] = __builtin_bit_cast(bf16x8s, (u32x4){nlo[s][dh].x, nlo[s][dh].y, nhi[s][dh].x, nhi[s][dh].y});
            SB_LOADT(k0 - 32);
            f32x16 x;
#pragma unroll
            for (int i = 0; i < 16; ++i) x[i] = 0.f;
#pragma unroll
            for (int ks = 0; ks < 4; ++ks) x = MFMA32(ak[ks], bq[ks], x);
            const bool diag = (k0 == q0);
            float z[16], ls[16], w[16];
#pragma unroll
            for (int i = 0; i < 16; ++i) { z[i] = x[i] * 0.125f; const bool valid = !diag || (((i & 3) + 8 * (i >> 2) + 4 * hh) < r); ls[i] = valid ? -softplusf_(z[i]) : 0.f; }
            float acc = after;
#pragma unroll
            for (int g = 3; g >= 0; --g) { const float G = (ls[4 * g] + ls[4 * g + 1]) + (ls[4 * g + 2] + ls[4 * g + 3]); const float tot = sb_pairsum(G);
                const float base = acc + (hh == 0 ? tot - G : 0.f);
                const float c3 = base + ls[4 * g + 3], c2 = c3 + ls[4 * g + 2], c1 = c2 + ls[4 * g + 1], c0 = c1 + ls[4 * g];
                w[4 * g + 3] = __expf(z[4 * g + 3] + c3); w[4 * g + 2] = __expf(z[4 * g + 2] + c2); w[4 * g + 1] = __expf(z[4 * g + 1] + c1); w[4 * g] = __expf(z[4 * g] + c0);
                acc += tot; }
            after = acc;
            if (diag) {
#pragma unroll
                for (int i = 0; i < 16; ++i) if (!(((i & 3) + 8 * (i >> 2) + 4 * hh) < r)) w[i] = 0.f; }
            const bf16x8s xs0 = sb_pack8(w[0], w[1], w[2], w[3], w[4], w[5], w[6], w[7]), xs1 = sb_pack8(w[8], w[9], w[10], w[11], w[12], w[13], w[14], w[15]);
            o0 = MFMA32(xs0, pb[0][0], o0); o0 = MFMA32(xs1, pb[1][0], o0); o1 = MFMA32(xs0, pb[0][1], o1); o1 = MFMA32(xs1, pb[1][1], o1);
            if (__all((after + bound < -104.f) ? 1 : 0)) break;
        }
        bf16_t* op = MX + ((size_t)b * SEQ + q0) * 1024 + 512 + h * 64 + r;
#pragma unroll
        for (int i = 0; i < 16; ++i) { const int qr = (i & 3) + 8 * (i >> 2) + 4 * hh; op[(size_t)qr * 1024] = (bf16_t)f2bf(o0[i]); op[(size_t)qr * 1024 + 32] = (bf16_t)f2bf(o1[i]); }
    }
}
__device__ __forceinline__ void rk_unp8(u32x4 w, float (&f)[8]) { f[0] = bflo(w.x); f[1] = bfhi(w.x); f[2] = bflo(w.y); f[3] = bfhi(w.y); f[4] = bflo(w.z); f[5] = bfhi(w.z); f[6] = bflo(w.w); f[7] = bfhi(w.w); }
PH_FN void ph_ret_kv(ArgsR a, LAS unsigned char* lds) {
    bf16_t* PJ = (bf16_t*)(a.ws + WS_PJ); bf16_t* KV = (bf16_t*)(a.ws + WS_KV);
    const float* cosT = (const float*)(a.ws + WS_ROPE); const float* sinT = cosT + SEQ * 32;
    const int tid = ltid(), lane = tid & 63, wave = tid >> 6, r = lane & 31, hh = lane >> 5;
    LAS bf16_t* kdt = (LAS bf16_t*)(lds + wave * 17408); LAS bf16_t* vtl = kdt + 64 * 68;
    for (int cu = blockIdx.x * 8 + wave; cu < 4096; cu += gridDim.x * 8) {
        const int b = cu >> 11, c = (cu >> 3) & 255, h = cu & 7, tok0 = b * SEQ + c * 64;
        const float lg = ret_logg(h), dk = __expf((float)(63 - lane) * lg);
        bf16_t* qp = PJ + (size_t)(tok0 + lane) * INW + C_RQ + h * 64; bf16_t* kp = PJ + (size_t)(tok0 + lane) * INW + C_RK + h * 64; const bf16_t* vp = PJ + (size_t)(tok0 + lane) * INW + C_RV + h * 64;
        const float* cp = cosT + (size_t)(c * 64 + lane) * 32; const float* sp = sinT + (size_t)(c * 64 + lane) * 32;
        f32x4 c0a[4], c1a[4], s0a[4], s1a[4]; u32x4 kla[4], kha[4], qla[4], qha[4];
#pragma unroll
        for (int g = 0; g < 4; ++g) { c0a[g] = *(const f32x4*)(cp + 8 * g); c1a[g] = *(const f32x4*)(cp + 8 * g + 4); s0a[g] = *(const f32x4*)(sp + 8 * g); s1a[g] = *(const f32x4*)(sp + 8 * g + 4);
            kla[g] = *(const u32x4*)(kp + 8 * g); kha[g] = *(const u32x4*)(kp + 32 + 8 * g); qla[g] = *(const u32x4*)(qp + 8 * g); qha[g] = *(const u32x4*)(qp + 32 + 8 * g); }
        u32x4 vra[8];
#pragma unroll
        for (int q = 0; q < 8; ++q) vra[q] = *(const u32x4*)(vp + 8 * q);
#pragma unroll
        for (int g = 0; g < 4; ++g) {
            const f32x4 c0 = c0a[g], c1 = c1a[g], s0 = s0a[g], s1 = s1a[g];
            const float cs[8] = {c0.x, c0.y, c0.z, c0.w, c1.x, c1.y, c1.z, c1.w}, sn[8] = {s0.x, s0.y, s0.z, s0.w, s1.x, s1.y, s1.z, s1.w};
            float k1[8], k2[8], q1[8], q2[8];
            rk_unp8(kla[g], k1); rk_unp8(kha[g], k2); rk_unp8(qla[g], q1); rk_unp8(qha[g], q2);
            unsigned ka[8], kb[8]; float qa[8], qb[8];
#pragma unroll
            for (int t = 0; t < 8; ++t) { ka[t] = f2bf((k1[t] * cs[t] - k2[t] * sn[t]) * 0.125f); kb[t] = f2bf((k1[t] * sn[t] + k2[t] * cs[t]) * 0.125f); qa[t] = q1[t] * cs[t] - q2[t] * sn[t]; qb[t] = q1[t] * sn[t] + q2[t] * cs[t]; }
            *(u32x4*)(kp + 8 * g) = (u32x4){ka[0] | (ka[1] << 16), ka[2] | (ka[3] << 16), ka[4] | (ka[5] << 16), ka[6] | (ka[7] << 16)};
            *(u32x4*)(kp + 32 + 8 * g) = (u32x4){kb[0] | (kb[1] << 16), kb[2] | (kb[3] << 16), kb[4] | (kb[5] << 16), kb[6] | (kb[7] << 16)};
            *(u32x4*)(qp + 8 * g) = (u32x4){pk2(qa[0], qa[1]), pk2(qa[2], qa[3]), pk2(qa[4], qa[5]), pk2(qa[6], qa[7])};
            *(u32x4*)(qp + 32 + 8 * g) = (u32x4){pk2(qb[0], qb[1]), pk2(qb[2], qb[3]), pk2(qb[4], qb[5]), pk2(qb[6], qb[7])};
#pragma unroll
            for (int t = 0; t < 8; ++t) { kdt[(8 * g + t) * 68 + lane] = (bf16_t)f2bf(__uint_as_float(ka[t] << 16) * dk); kdt[(32 + 8 * g + t) * 68 + lane] = (bf16_t)f2bf(__uint_as_float(kb[t] << 16) * dk); }
        }
#pragma unroll
        for (int q = 0; q < 8; ++q) { const u32x4 w = vra[q]; LAS bf16_t* d = vtl + (8 * q) * 68 + lane;
            d[0] = (bf16_t)(w.x & 0xffffu); d[68] = (bf16_t)(w.x >> 16); d[2 * 68] = (bf16_t)(w.y & 0xffffu); d[3 * 68] = (bf16_t)(w.y >> 16);
            d[4 * 68] = (bf16_t)(w.z & 0xffffu); d[5 * 68] = (bf16_t)(w.z >> 16); d[6 * 68] = (bf16_t)(w.w & 0xffffu); d[7 * 68] = (bf16_t)(w.w >> 16); }
        asm volatile("" ::: "memory");
        bf16_t* outp = KV + ((size_t)((b * 8 + h) * 256 + c)) * 4096;
#pragma unroll
        for (int db = 0; db < 2; ++db)
#pragma unroll
            for (int eb = 0; eb < 2; ++eb) { f32x16 x;
#pragma unroll
                for (int i = 0; i < 16; ++i) x[i] = 0.f;
#pragma unroll
                for (int ks = 0; ks < 4; ++ks) { const LAS bf16_t* ap = kdt + (32 * db + r) * 68 + 16 * ks + 8 * hh; const LAS bf16_t* bp = vtl + (32 * eb + r) * 68 + 16 * ks + 8 * hh;
                    const u32x2 a0 = *(const LAS u32x2*)ap, a1 = *(const LAS u32x2*)(ap + 4), b0 = *(const LAS u32x2*)bp, b1 = *(const LAS u32x2*)(bp + 4);
                    x = MFMA32(__builtin_bit_cast(bf16x8s, (u32x4){a0.x, a0.y, a1.x, a1.y}), __builtin_bit_cast(bf16x8s, (u32x4){b0.x, b0.y, b1.x, b1.y}), x); }
#pragma unroll
                for (int gq = 0; gq < 4; ++gq) *(u32x2*)(outp + (size_t)(32 * eb + r) * 64 + 32 * db + 8 * gq + 4 * hh) = (u32x2){pk2(x[4 * gq], x[4 * gq + 1]), pk2(x[4 * gq + 2], x[4 * gq + 3])}; }
        asm volatile("" ::: "memory");
    }
}
PH_FN void ph_ret_out(ArgsR a, int L, LAS unsigned char* lds) {
    const bf16_t* PJ = (const bf16_t*)(a.ws + WS_PJ); const bf16_t* KV = (const bf16_t*)(a.ws + WS_KV); bf16_t* MX = (bf16_t*)(a.ws + WS_MX);
    const float* ng = a.in[6] + L * 512;
    const int tid = ltid(), lane = tid & 63, wave = tid >> 6, r = lane & 31, hh = lane >> 5;
    LAS bf16_t* vtl = (LAS bf16_t*)(lds + wave * 9216);
    for (int cu = blockIdx.x * 8 + wave; cu < 4096; cu += gridDim.x * 8) {
        const int b = cu >> 11, c = (cu >> 3) & 255, h = cu & 7, tok0 = b * SEQ + c * 64;
        const float lg = ret_logg(h);
        { const bf16_t* vp = PJ + (size_t)(tok0 + lane) * INW + C_RV + h * 64;
#pragma unroll
            for (int q = 0; q < 8; ++q) { const u32x4 w = *(const u32x4*)(vp + 8 * q); LAS bf16_t* d = vtl + (8 * q) * 68 + lane;
                d[0] = (bf16_t)(w.x & 0xffffu); d[68] = (bf16_t)(w.x >> 16); d[2 * 68] = (bf16_t)(w.y & 0xffffu); d[3 * 68] = (bf16_t)(w.y >> 16);
                d[4 * 68] = (bf16_t)(w.z & 0xffffu); d[5 * 68] = (bf16_t)(w.z >> 16); d[6 * 68] = (bf16_t)(w.w & 0xffffu); d[7 * 68] = (bf16_t)(w.w >> 16); } }
        asm volatile("" ::: "memory");
        const bf16_t* Rt = KV + ((size_t)((b * 8 + h) * 256 + c)) * 4096;
        const float ng0 = ng[h * 64 + r], ng1 = ng[h * 64 + 32 + r];
#pragma unroll 1
        for (int qh = 0; qh < 2; ++qh) {
            bf16x8s bq[4];
            { const bf16_t* qp = PJ + (size_t)(tok0 + 32 * qh + r) * INW + C_RQ + h * 64 + 8 * hh;
#pragma unroll
                for (int ks = 0; ks < 4; ++ks) bq[ks] = __builtin_bit_cast(bf16x8s, *(const u32x4*)(qp + 16 * ks)); }
            unsigned short gq0[16], gq1[16];
#pragma unroll
            for (int i = 0; i < 16; ++i) { const size_t tk = (size_t)tok0 + 32 * qh + (i & 3) + 8 * (i >> 2) + 4 * hh; gq0[i] = PJ[tk * INW + C_RG + h * 64 + r]; gq1[i] = PJ[tk * INW + C_RG + h * 64 + 32 + r]; }
            f32x16 o0, o1, oc0, oc1;
#pragma unroll
            for (int i = 0; i < 16; ++i) { o0[i] = 0.f; o1[i] = 0.f; oc0[i] = 0.f; oc1[i] = 0.f; }
#pragma unroll
            for (int kh = 0; kh < 2; ++kh) {
                bf16x8s ak[4];
                { const bf16_t* kp = PJ + (size_t)(tok0 + 32 * kh + r) * INW + C_RK + h * 64 + 8 * hh;
#pragma unroll
                    for (int ks = 0; ks < 4; ++ks) ak[ks] = __builtin_bit_cast(bf16x8s, *(const u32x4*)(kp + 16 * ks)); }
                f32x16 x;
#pragma unroll
                for (int i = 0; i < 16; ++i) x[i] = 0.f;
#pragma unroll
                for (int ks = 0; ks < 4; ++ks) x = MFMA32(ak[ks], bq[ks], x);
                float w[16];
#pragma unroll
                for (int i = 0; i < 16; ++i) { const int j = 32 * kh + (i & 3) + 8 * (i >> 2) + 4 * hh; w[i] = x[i] * __expf(lg * fabsf((float)(32 * qh + r - j))); }
                const bf16x8s xs0 = sb_pack8(w[0], w[1], w[2], w[3], w[4], w[5], w[6], w[7]), xs1 = sb_pack8(w[8], w[9], w[10], w[11], w[12], w[13], w[14], w[15]);
                bf16x8s pb[2][2];
#pragma unroll
                for (int s = 0; s < 2; ++s)
#pragma unroll
                    for (int dh = 0; dh < 2; ++dh) { const LAS bf16_t* vq = vtl + (32 * dh + r) * 68 + 32 * kh + 16 * s + 4 * hh; const u32x2 lo = *(const LAS u32x2*)(vq), hi = *(const LAS u32x2*)(vq + 8);
                        pb[s][dh] = __builtin_bit_cast(bf16x8s, (u32x4){lo.x, lo.y, hi.x, hi.y}); }
                o0 = MFMA32(xs0, pb[0][0], o0); o0 = MFMA32(xs1, pb[1][0], o0); o1 = MFMA32(xs0, pb[0][1], o1); o1 = MFMA32(xs1, pb[1][1], o1);
            }
#pragma unroll
            for (int ks = 0; ks < 4; ++ks) { const bf16x8s r0 = __builtin_bit_cast(bf16x8s, *(const u32x4*)(Rt + (size_t)r * 64 + 16 * ks + 8 * hh)), r1 = __builtin_bit_cast(bf16x8s, *(const u32x4*)(Rt + (size_t)(32 + r) * 64 + 16 * ks + 8 * hh));
                oc0 = MFMA32(bq[ks], r0, oc0); oc1 = MFMA32(bq[ks], r1, oc1); }
#pragma unroll
            for (int i = 0; i < 16; ++i) { const int qi = 32 * qh + (i & 3) + 8 * (i >> 2) + 4 * hh; const float f = __expf((float)(qi + 1) * lg);
                const float v0 = o0[i] + f * oc0[i], v1 = o1[i] + f * oc1[i];
                float ss = allred16(v0 * v0 + v1 * v1); ss += __shfl_xor(ss, 16);
                const float rstd = rsqrtf(ss * (1.f / 64.f) + 1e-6f);
                const size_t tok = (size_t)tok0 + qi;
                const float g0 = bf2f(gq0[i]), g1 = bf2f(gq1[i]);
                MX[tok * 1024 + h * 64 + r] = (bf16_t)f2bf(g0 * sigmoidf_(g0) * v0 * rstd * ng0); MX[tok * 1024 + h * 64 + 32 + r] = (bf16_t)f2bf(g1 * sigmoidf_(g1) * v1 * rstd * ng1); }
        }
        asm volatile("" ::: "memory");
    }
}
PH_FN void ph_rwkv_post(ArgsR a, int L) {
    const int tid = ltid(), lane = tid & 63, wave = tid >> 6, c4 = 4 * lane;
    const bf16_t* RW_R = (const bf16_t*)(a.ws + WS_NB); const bf16_t* RW_KM = RW_R + (size_t)TT * 256; const bf16_t* RW_V = RW_KM + (size_t)TT * 256;
    const bf16_t* RW_G = (const bf16_t*)(a.ws + WS_PJ + 240 * MiB); bf16_t* MX = (bf16_t*)(a.ws + WS_MX);
    const f32x4 rk = *(const f32x4*)(a.in[15] + L * 256 + c4), lw = *(const f32x4*)(a.in[16] + L * 256 + c4), lb = *(const f32x4*)(a.in[17] + L * 256 + c4);
    for (int tok = blockIdx.x * 8 + wave; tok < TT; tok += gridDim.x * 8) { const size_t idx = (size_t)tok * 256 + c4; bf16_t* yp = MX + (size_t)tok * 1024 + 768 + c4;
        const f32x4 y = bf4(*(const u32x2*)yp), r = bf4(*(const u32x2*)(RW_R + idx)), km = bf4(*(const u32x2*)(RW_KM + idx)), v = bf4(*(const u32x2*)(RW_V + idx)), g = bf4(*(const u32x2*)(RW_G + idx));
        const float mean = allred16((y.x + y.y) + (y.z + y.w)) * (1.f / 64.f); const f32x4 d = y - mean;
        const float var = allred16((d.x * d.x + d.y * d.y) + (d.z * d.z + d.w * d.w)) * (1.f / 64.f);
        const f32x4 t = r * km * rk; const float bon = allred16((t.x + t.y) + (t.z + t.w));
        const f32x4 o = (d * rsqrtf(var + 64e-5f) * lw + lb + v * bon) * g;
        *(u32x2*)yp = (u32x2){pk2(o.x, o.y), pk2(o.z, o.w)}; }
}
#define XB_TMO      128
#define XB_XCNT(j)  (256  + 64 * (j))
#define XB_XSUB(j)  (1280 + 64 * (j))
#define XB_XGEN(j)  (2304 + 64 * (j))
#define XB_TOP      3328
#define XB_TOPGEN   3392
#define XCD_BAR_WORDS 3456
#define XB_SPIN_CAP (1u << 18)

__device__ __forceinline__ unsigned xb_ld(unsigned* p)              { return __hip_atomic_load(p, __ATOMIC_RELAXED, __HIP_MEMORY_SCOPE_AGENT); }
__device__ __forceinline__ unsigned xb_add(unsigned* p, unsigned v) { return __hip_atomic_fetch_add(p, v, __ATOMIC_RELAXED, __HIP_MEMORY_SCOPE_AGENT); }
__device__ __forceinline__ unsigned xb_xcc_id() { return (unsigned)__builtin_amdgcn_s_getreg((3 << 11) | 20) & 0xFu; }
#define XB_SPIN(cond, bar) do { unsigned _sp = 0; while (cond) { __builtin_amdgcn_s_sleep(1); \
    if ((++_sp & 255u) == 0u) { if (xb_ld(&(bar)[XB_TMO])) break; if (_sp > XB_SPIN_CAP) { atomicAdd(&(bar)[XB_TMO], 1u); break; } } } } while (0)

struct XcdBarrier {
    unsigned* bar; unsigned x;
    volatile LAS unsigned* st;
};

__device__ __forceinline__ XcdBarrier xcd_barrier_post(unsigned* bar, volatile LAS unsigned* st) {
    XcdBarrier b; b.bar = bar; b.x = xb_xcc_id(); b.st = st;
    if (threadIdx.x == 0) (void)xb_add(&bar[XB_XCNT(b.x)], 1u);
    return b;
}
__device__ __forceinline__ void xcd_barrier_complete(unsigned* bar, unsigned x, unsigned& nloc, unsigned& nx) {
    const unsigned G = gridDim.x * gridDim.y * gridDim.z;
    unsigned sum, cnt, mine, sp = 0u;
    for (;;) {
        sum = 0u; cnt = 0u; mine = 0u;
#pragma unroll
        for (unsigned j = 0; j < 16; ++j) { const unsigned c = xb_ld(&bar[XB_XCNT(j)]); sum += c; cnt += (c > 0u) ? 1u : 0u; mine = (j == x) ? c : mine; }
        if (sum == G) break;
        __builtin_amdgcn_s_sleep(1);
        if ((++sp & 255u) == 0u) { if (xb_ld(&bar[XB_TMO])) break; if (sp > XB_SPIN_CAP) { atomicAdd(&bar[XB_TMO], 1u); break; } }
    }
    nloc = mine > 0u ? mine : 1u; nx = cnt > 0u ? cnt : 1u;
}

__device__ __forceinline__ void xcd_barrier(const XcdBarrier& b) {
    asm volatile("s_waitcnt vmcnt(0)" ::: "memory");
    __syncthreads();
    if (threadIdx.x == 0) {
        unsigned* bar = b.bar;
        __builtin_amdgcn_s_waitcnt(0);
        unsigned nloc = b.st[0], nx = b.st[1];
        if (nloc == 0u) { xcd_barrier_complete(bar, b.x, nloc, nx); b.st[0] = nloc; b.st[1] = nx; }
        const unsigned old = xb_add(&bar[XB_XSUB(b.x)], 1u);
        const unsigned gen = old / nloc;
        if (old + 1u == (gen + 1u) * nloc) {
            __builtin_amdgcn_fence(__ATOMIC_RELEASE, "agent");
            asm volatile("s_waitcnt vmcnt(0)" ::: "memory");
            const unsigned og = xb_add(&bar[XB_TOP], 1u);
            const unsigned tg = og / nx;
            if (og + 1u == (tg + 1u) * nx) xb_add(&bar[XB_TOPGEN], 1u);
            else XB_SPIN(xb_ld(&bar[XB_TOPGEN]) == tg, bar);
            __builtin_amdgcn_fence(__ATOMIC_ACQUIRE, "agent");
            xb_add(&bar[XB_XGEN(b.x)], 1u);
            asm volatile("s_waitcnt vmcnt(0)" ::: "memory");
        } else {
            XB_SPIN(xb_ld(&bar[XB_XGEN(b.x)]) == gen, bar);
            __builtin_amdgcn_fence(__ATOMIC_ACQUIRE, "agent");
            asm volatile("s_waitcnt vmcnt(0)" ::: "memory");
        }
    }
    __syncthreads();
}
#ifndef EN_MASK
#define EN_MASK 0xffff
#endif
#define EN(i) ((EN_MASK >> (i)) & 1)
#ifndef REP_MASK
#define REP_MASK 0
#endif
#define REP(i) (((REP_MASK >> (i)) & 1) ? 2 : 1)
#ifndef MK_PER_PHASE
#define MK_PER_PHASE 0
#endif
__global__ void __launch_bounds__(512, 2) mk_fwd(Args a_) {
    extern __shared__ __attribute__((aligned(16))) unsigned char lds_raw[];
    LAS unsigned char* lds = (LAS unsigned char*)lds_raw;
    const int G = gridDim.x, bid = blockIdx.x;
    const int ph_lo = a_.ph_lo, ph_hi = a_.ph_hi;
    volatile LAS unsigned* bst = (volatile LAS unsigned*)(lds + LDS_BYTES - 256);
    if (threadIdx.x < 2) bst[threadIdx.x] = 0u;
    __syncthreads();
    XcdBarrier xbar = xcd_barrier_post((unsigned*)(a_.ws + WS_CTL) + 1024, bst);
    for (int ph = ph_lo; ph < ph_hi; ++ph) {
        const __attribute__((address_space(4))) Args* ap = (const __attribute__((address_space(4))) Args*)__builtin_amdgcn_kernarg_segment_ptr();
        asm volatile("" : "+s"(ap));
        ArgsR a = *ap;
        bf16_t* WB = (bf16_t*)(a.ws + WS_WB); bf16_t* NB = (bf16_t*)(a.ws + WS_NB); bf16_t* PJ = (bf16_t*)(a.ws + WS_PJ); bf16_t* MX = (bf16_t*)(a.ws + WS_MX); bf16_t* PB = (bf16_t*)(a.ws + WS_KV);
        int ngemm = 0; pg8::Gemm g0{nullptr, nullptr, 0, 0, 0}, g1 = g0; pg8::EpiGen e0{0, true, nullptr, 0, nullptr, nullptr, nullptr, nullptr, nullptr, nullptr}, e1 = e0;
        unsigned long long* RSS = (unsigned long long*)(a.ws + WS_RSS);
        if (ph == 0) { if (EN(11)) ph_prologue(a); }
        else if (ph == NPHASE - 1) { if (EN(12)) ph_final(RSS + 12 * TT, a.in[23], a.out); }
        else {
            const int L = (ph - 1) / NSUB, s = (ph - 1) % NSUB;
            if (s == 0) { ph_weights(a, L, lds); }
            else if (s == 1) { ngemm = 1; g0 = pg8::Gemm{MX, WB + WB_IN, TT, INW, DM}; e0 = pg8::EpiGen{0, true, PJ, INW, nullptr, nullptr, nullptr, nullptr, RSS + (3 * L) * TT, nullptr}; }
            else if (s == 2) { _Pragma("nounroll") for (int rp = 0; rp < REP(2); ++rp) ph_ret_kv(a, lds); __syncthreads();     _Pragma("nounroll") for (int rp = 0; rp < REP(15); ++rp) ph_rwkv_prep(a, L, lds); }
            else if (s == 3) { { _Pragma("nounroll") for (int rp = 0; rp < REP(3); ++rp) for (int u = bid; u < 8 * (SC_NC - 1); u += G) ph_scan_pass<1>(a, lds, u, L); } }
            else if (s == 4) { if (bid < 32) ph_scan_combine(a, lds, bid); else { if (bid >= G - 64) ph_ret_scan(a, bid - (G - 64)); _Pragma("nounroll") for (int rp = 0; rp < REP(13); ++rp) ph_sb(a, L, bid - 32, G - 32); } }
            else if (s == 5) { _Pragma("nounroll") for (int rp = 0; rp < REP(14); ++rp) for (int u = bid; u < 8 * SC_NC; u += G) ph_scan_pass<2>(a, lds, u, L); }
            else if (s == 6) { _Pragma("nounroll") for (int rp = 0; rp < REP(4); ++rp) ph_ret_out(a, L, lds); }
            else if (s == 7) { ph_pconv(a.in[1] + (size_t)L * TT * PLE, PB); ngemm = 1; g0 = pg8::Gemm{MX, WB + WB_O, TT, DM, DM}; e0 = pg8::EpiGen{2, true, nullptr, DM, L == 0 ? a.in[0] : a.out, a.out, NB, nullptr, nullptr, RSS + (3 * L + 1) * TT}; }
            else if (s == 8) { ngemm = 2; g0 = pg8::Gemm{NB, WB + WB_1, TT, DFF, DM}; e0 = pg8::EpiGen{1, true, PJ, DFF, nullptr, nullptr, nullptr, nullptr, RSS + (3 * L + 1) * TT, nullptr};
                g1 = pg8::Gemm{PB, WB + WB_PE, TT, DM, PLE}; e1 = pg8::EpiGen{0, true, MX, DM, nullptr, nullptr, nullptr, nullptr, nullptr, nullptr}; }
            else if (s == 9) { ngemm = 1; g0 = pg8::Gemm{PJ, WB + WB_2, TT, DM, DFF}; e0 = pg8::EpiGen{2, true, nullptr, DM, a.out, a.out, NB, nullptr, nullptr, RSS + (3 * L + 2) * TT}; }
            else { ngemm = 1; g0 = pg8::Gemm{NB, WB + WB_PG, TT, DM, DM}; e0 = pg8::EpiGen{3, true, nullptr, DM, a.out, a.out, MX, MX, RSS + (3 * L + 2) * TT, RSS + (3 * L + 3) * TT}; }
        }
        const int grep_ = 1;
        for (int gi = 0; gi < ngemm * grep_; ++gi) {
            const pg8::Gemm g = (gi % ngemm) ? g1 : g0; const pg8::EpiGen E = (gi % ngemm) ? e1 : e0;
            pg8::StaticOrder S; S.init(g.M, g.N, G, bid);
            pg8::gemm_phase<pg8::EpiGen, pg8::StaticOrder, true, true>(lds, g, S, E);
            __syncthreads();
        }
        if (ph + 1 < ph_hi) { if (ph == ph_lo) cg::this_grid().sync(); else xcd_barrier(xbar); }
    }
}

extern "C" void kernel_launch(void* const* d_in, const int* in_sizes, int n_in, void* d_out, int out_size, void* d_ws, size_t ws_size, hipStream_t stream) {
    static int grid = 0;
    if (grid == 0) {
        if (n_in != 24 || out_size != TT * DM || ws_size < WS_END) { fprintf(stderr, "kernel_launch: unexpected shapes (n_in %d, out %d, ws %zu); nothing launched\n", n_in, out_size, ws_size); grid = -1; return; }
        int dev = 0, cus = 0, per_cu = 0;
        (void)hipGetDevice(&dev); (void)hipDeviceGetAttribute(&cus, hipDeviceAttributeMultiprocessorCount, dev);
        if (hipFuncSetAttribute((const void*)mk_fwd, hipFuncAttributeMaxDynamicSharedMemorySize, LDS_BYTES) != hipSuccess) fprintf(stderr, "kernel_launch: hipFuncSetAttribute failed\n");
        if (hipOccupancyMaxActiveBlocksPerMultiprocessor(&per_cu, (const void*)mk_fwd, 512, LDS_BYTES) != hipSuccess || per_cu < 1) { fprintf(stderr, "kernel_launch: occupancy query says %d\n", per_cu); per_cu = 1; }
        (void)hipGetLastError();
        grid = cus * 1;
        if (grid <= 16) grid = 256;
    }
    if (grid < 0) return;
    (void)hipMemsetAsync((char*)d_ws + WS_CTL, 0, 65536, stream);
    Args a{};
    for (int i = 0; i < 24; ++i) a.in[i] = (const float*)d_in[i];
    a.out = (float*)d_out; a.ws = (unsigned char*)d_ws;
#if MK_PER_PHASE
    for (int ph = 0; ph < NPHASE; ++ph) { a.ph_lo = ph; a.ph_hi = ph + 1; hipLaunchKernelGGL(mk_fwd, dim3(grid), dim3(512), LDS_BYTES, stream, a); }
#else
    a.ph_lo = 0; a.ph_hi = NPHASE;
    void* args[] = {&a};
    hipError_t e = hipLaunchCooperativeKernel((void*)mk_fwd, dim3(grid), dim3(512), args, LDS_BYTES, stream);
    if (e != hipSuccess) fprintf(stderr, "cooperative launch failed: %s (grid %d)\n", hipGetErrorString(e), grid);
#endif
}
```

```cpp
#include <hip/hip_runtime.h>
#include <hip/hip_cooperative_groups.h>
#include <cstdio>
#include <cstdint>
namespace cg = cooperative_groups;
namespace pg8 {
#define PG8_LAS __attribute__((address_space(3)))
typedef unsigned short bf16_t;
typedef short bf16x8 __attribute__((ext_vector_type(8)));
typedef float f32x4 __attribute__((ext_vector_type(4)));
typedef unsigned u32x4 __attribute__((ext_vector_type(4)));
constexpr int BM = 256, BK = 64, HALF = 128, HTB = HALF * BK * 2  , STAGE_BYTES = 8 * HTB, NXCD = 8, WGM = 8;

__host__ __device__ __forceinline__ int lds_byte(int r, int c) { const int st = (r >> 4) * 2 + (c >> 5), rr = r & 15, cc = c & 31, ob = rr * 64 + cc * 2; return st * 1024 + (ob ^ (((ob >> 9) & 1) << 5)); }
__host__ __device__ __forceinline__ void stage_rc(int b, int& R, int& C) { const int st = b / 1024, sb = b % 1024, swz = sb ^ (((sb >> 9) & 1) << 5); R = (st >> 1) * 16 + swz / 64; C = (st & 1) * 32 + (swz % 64) / 2; }
__host__ __device__ __forceinline__ int perm32(int rho) { const int n = rho >> 4, i = rho & 15; return 8 * (i >> 2) + 4 * n + (i & 3); }

struct Unit { int pm, pn; };
struct Gemm { const bf16_t* A; const bf16_t* Bt; int M, N, K; };

struct StaticOrder {
    int nM, nN, nwg, G, c;
    __host__ __device__ void init(int M, int N, int G_, int c_) { nM = M / BM; nN = N / BM; nwg = nM * nN; G = G_; c = c_; }
    __host__ __device__ bool next(int i, Unit& u) const {
        const long L = (long)i * G + c; if (L >= nwg) return false;
        int wgid = (int)L; { const int q = nwg / NXCD, r = nwg % NXCD, xcd = wgid % NXCD, off = wgid / NXCD; wgid = (xcd < r ? xcd * (q + 1) : r * (q + 1) + (xcd - r) * q) + off; }
        const int nig = WGM * nN, gid = wgid / nig, fm = gid * WGM, gsz = (nM - fm) < WGM ? (nM - fm) : WGM;
        u.pm = fm + ((wgid % nig) % gsz); u.pn = (wgid % nig) / gsz; return true;
    }
    __device__ __forceinline__ void a_ready(const Unit&) const {}
    __device__ __forceinline__ void done(const Unit&) const {}
};

__device__ __forceinline__ unsigned cvt_pk_bf16(float lo, float hi) { unsigned r; asm volatile("v_cvt_pk_bf16_f32 %0, %1, %2" : "=v"(r) : "v"(lo), "v"(hi)); return r; }
template <int ACT> struct EpiBf16 {
    static constexpr bool PERM = true, AFTER_DRAIN = false;
    bf16_t* O; int ldc;
    __device__ __forceinline__ void operator()(const f32x4 (&acc)[2][2][4][2], const Unit& u, int wr, int wc, int fr, int fq) const {
        const int row0 = u.pm * BM + wr * 64 + fr; const int col0 = u.pn * BM + wc * 32 + 8 * fq;
#pragma unroll
        for (int ai = 0; ai < 2; ++ai)
#pragma unroll
            for (int m = 0; m < 4; ++m) { bf16_t* rowp = O + (size_t)(row0 + ai * HALF + m * 16) * ldc + col0;
#pragma unroll
                for (int bj = 0; bj < 2; ++bj) { f32x4 v0 = acc[ai][bj][m][0], v1 = acc[ai][bj][m][1];
                    if (ACT == 1) {
#pragma unroll
                        for (int q = 0; q < 4; ++q) { float a = fmaxf(v0[q], 0.f), b = fmaxf(v1[q], 0.f); v0[q] = a * a; v1[q] = b * b; } }
                    u32x4 w; w.x = cvt_pk_bf16(v0[0], v0[1]); w.y = cvt_pk_bf16(v0[2], v0[3]); w.z = cvt_pk_bf16(v1[0], v1[1]); w.w = cvt_pk_bf16(v1[2], v1[3]);
                    *(u32x4*)(rowp + bj * HALF) = w; } }
    }
};
template <int GATE> struct EpiRes {
    static constexpr bool PERM = false, AFTER_DRAIN = false;
    const float* base; float* out; const bf16_t* pe; int ldc;
    __device__ __forceinline__ void operator()(const f32x4 (&acc)[2][2][4][2], const Unit& u, int wr, int wc, int fr, int fq) const {
        const int col0 = u.pn * BM + wc * 32 + 4 * fq;
#pragma unroll
        for (int ai = 0; ai < 2; ++ai)
#pragma unroll
            for (int m = 0; m < 4; ++m) { const size_t off = (size_t)(u.pm * BM + ai * HALF + wr * 64 + m * 16 + fr) * ldc + col0;
#pragma unroll
                for (int bj = 0; bj < 2; ++bj)
#pragma unroll
                    for (int n = 0; n < 2; ++n) { const size_t o2 = off + bj * HALF + n * 16; const f32x4 bs = *(const f32x4*)(base + o2); f32x4 a = acc[ai][bj][m][n];
                        if (GATE) { const uint2 pw = *(const uint2*)(pe + o2); float p0 = __uint_as_float(pw.x << 16), p1 = __uint_as_float(pw.x & 0xffff0000u), p2 = __uint_as_float(pw.y << 16), p3 = __uint_as_float(pw.y & 0xffff0000u);
                            a[0] = p0 / (1.f + __expf(-a[0])); a[1] = p1 / (1.f + __expf(-a[1])); a[2] = p2 / (1.f + __expf(-a[2])); a[3] = p3 / (1.f + __expf(-a[3])); }
                        *(f32x4*)(out + o2) = bs + a; } }
    }
};

struct EpiGen {
    static constexpr bool AFTER_DRAIN = false;
    int mode; bool perm; bf16_t* O; int ldc; const float* hbase; float* hout; bf16_t* hcopy; const bf16_t* pe; const unsigned long long* rss_in; unsigned long long* rss_out;
    __device__ __forceinline__ void operator()(const f32x4 (&acc)[2][2][4][2], const Unit& u, int wr, int wc, int fr, int fq) const {
        if (mode < 2) {
            const int row0 = u.pm * BM + wr * 64 + fr; const int col0 = u.pn * BM + wc * 32 + 8 * fq; const bool sq = (mode == 1);
#pragma unroll
            for (int ai = 0; ai < 2; ++ai)
#pragma unroll
                for (int m = 0; m < 4; ++m) { const int row = row0 + ai * HALF + m * 16; bf16_t* rowp = O + (size_t)row * ldc + col0;
                    const float rs = rss_in ? rsqrtf((float)rss_in[row] * (1.f / (1024.f * 1048576.f)) + 1e-6f) : 1.f;
#pragma unroll
                    for (int bj = 0; bj < 2; ++bj) { f32x4 v0 = acc[ai][bj][m][0] * rs, v1 = acc[ai][bj][m][1] * rs;
                        if (sq) {
#pragma unroll
                            for (int q = 0; q < 4; ++q) { float a = fmaxf(v0[q], 0.f), b = fmaxf(v1[q], 0.f); v0[q] = a * a; v1[q] = b * b; } }
                        u32x4 w; w.x = cvt_pk_bf16(v0[0], v0[1]); w.y = cvt_pk_bf16(v0[2], v0[3]); w.z = cvt_pk_bf16(v1[0], v1[1]); w.w = cvt_pk_bf16(v1[2], v1[3]);
                        *(u32x4*)(rowp + bj * HALF) = w; } }
        } else {
            const int col0 = u.pn * BM + wc * 32 + 8 * fq; const bool gate = (mode == 3);
#pragma unroll
            for (int ai = 0; ai < 2; ++ai) {
#pragma unroll
              for (int mp = 0; mp < 2; ++mp) {
                f32x4 pre[4][2][2]; u32x4 pq_[2][2];
#pragma unroll
                for (int m = 2 * mp; m < 2 * mp + 2; ++m) { const size_t off = (size_t)(u.pm * BM + ai * HALF + wr * 64 + m * 16 + fr) * ldc + col0;
#pragma unroll
                    for (int bj = 0; bj < 2; ++bj)
#pragma unroll
                        for (int n = 0; n < 2; ++n) pre[m][bj][n] = *(const f32x4*)(hbase + off + bj * HALF + n * 4);
                    if (gate) {
#pragma unroll
                        for (int bj = 0; bj < 2; ++bj) pq_[m & 1][bj] = *(const u32x4*)(pe + off + bj * HALF); } }
#pragma unroll
                for (int m = 2 * mp; m < 2 * mp + 2; ++m) { const int row = u.pm * BM + ai * HALF + wr * 64 + m * 16 + fr; const size_t off = (size_t)row * ldc + col0;
                    const float rs = gate ? rsqrtf((float)rss_in[row] * (1.f / (1024.f * 1048576.f)) + 1e-6f) : 1.f; float ssum = 0.f;
#pragma unroll
                    for (int bj = 0; bj < 2; ++bj) { const size_t o2 = off + bj * HALF; f32x4 a0 = acc[ai][bj][m][0], a1 = acc[ai][bj][m][1];
                        if (gate) { const u32x4 pq = pq_[m & 1][bj];
                            a0[0] = __uint_as_float(pq.x << 16) / (1.f + __expf(-a0[0] * rs)); a0[1] = __uint_as_float(pq.x & 0xffff0000u) / (1.f + __expf(-a0[1] * rs)); a0[2] = __uint_as_float(pq.y << 16) / (1.f + __expf(-a0[2] * rs)); a0[3] = __uint_as_float(pq.y & 0xffff0000u) / (1.f + __expf(-a0[3] * rs));
                            a1[0] = __uint_as_float(pq.z << 16) / (1.f + __expf(-a1[0] * rs)); a1[1] = __uint_as_float(pq.z & 0xffff0000u) / (1.f + __expf(-a1[1] * rs)); a1[2] = __uint_as_float(pq.w << 16) / (1.f + __expf(-a1[2] * rs)); a1[3] = __uint_as_float(pq.w & 0xffff0000u) / (1.f + __expf(-a1[3] * rs)); }
                        const f32x4 h0 = pre[m][bj][0] + a0, h1 = pre[m][bj][1] + a1;
                        ssum += ((h0[0] * h0[0] + h0[1] * h0[1]) + (h0[2] * h0[2] + h0[3] * h0[3])) + ((h1[0] * h1[0] + h1[1] * h1[1]) + (h1[2] * h1[2] + h1[3] * h1[3]));
                        *(f32x4*)(hout + o2) = h0; *(f32x4*)(hout + o2 + 4) = h1;
                        u32x4 ow; ow.x = cvt_pk_bf16(h0[0], h0[1]); ow.y = cvt_pk_bf16(h0[2], h0[3]); ow.z = cvt_pk_bf16(h1[0], h1[1]); ow.w = cvt_pk_bf16(h1[2], h1[3]); *(u32x4*)(hcopy + o2) = ow; }
                    ssum += __shfl_xor(ssum, 16); ssum += __shfl_xor(ssum, 32);
                    if (fq == 0) atomicAdd(rss_out + row, (unsigned long long)__float2ll_rn(ssum * 1048576.f)); }
              }
            }
        }
    }
};

template <class Epi, class Sched, bool ALIGN_EPI = false, bool SP2 = false>
__device__ __forceinline__ void gemm_phase(PG8_LAS unsigned char* lds, const Gemm g, const Sched& S, const Epi& E) {
    const int tid = threadIdx.x, wid = __builtin_amdgcn_readfirstlane(tid >> 6), lane = tid & 63, wr = wid >> 2, wc = wid & 3, fr = lane & 15, fq = lane >> 4;
    const int K = g.K, nt = K / BK;
    unsigned voffA[2], voffB[2];
#pragma unroll
    for (int i = 0; i < 2; ++i) { int R, C; stage_rc(tid * 16 + i * 8192, R, C); const int Rb = E.perm ? ((R & ~31) + perm32(R & 31)) : R;
        voffA[i] = (unsigned)(R * K + C) * 2u; voffB[i] = (unsigned)(Rb * K + C) * 2u; }
    const size_t kstep = (size_t)(BK * 2);
    const size_t hstep = (size_t)HALF * K * 2;
    const size_t tstep = 2 * hstep;
    const unsigned ldsw = (unsigned)wid * 1024u;
    const int aoff = lds_byte(wr * 64 + fr, fq * 8), boff = lds_byte(wc * 32 + fr, fq * 8);
#define PG8_SA(b, h) (((b) * 2 + (h)) * HTB)
#define PG8_SB(b, h) ((4 + (b) * 2 + (h)) * HTB)
#define PG8_STAGE(bufoff, gbase, voff) do { _Pragma("unroll") for (int _i = 0; _i < 2; ++_i) \
        __builtin_amdgcn_global_load_lds((const unsigned*)((const char*)(gbase) + (voff)[_i]), (PG8_LAS unsigned*)(lds + (bufoff) + ldsw + _i * 8192), 16, 0, 0); } while (0)
#define PG8_LDA(dst, b, h) do { _Pragma("unroll") for (int m = 0; m < 4; ++m) _Pragma("unroll") for (int k = 0; k < 2; ++k) dst[m][k] = *(const PG8_LAS bf16x8*)(lds + PG8_SA(b, h) + aoff + m * 2048 + k * 1024); } while (0)
#define PG8_LDB(dst, b, h) do { _Pragma("unroll") for (int n = 0; n < 2; ++n) _Pragma("unroll") for (int k = 0; k < 2; ++k) dst[n][k] = *(const PG8_LAS bf16x8*)(lds + PG8_SB(b, h) + boff + n * 2048 + k * 1024); } while (0)
#define PG8_MMA(ai, bj, At, Bt) do { __builtin_amdgcn_s_setprio(1); _Pragma("unroll") for (int m = 0; m < 4; ++m) _Pragma("unroll") for (int n = 0; n < 2; ++n) _Pragma("unroll") for (int k = 0; k < 2; ++k) \
        acc[ai][bj][m][n] = __builtin_amdgcn_mfma_f32_16x16x32_bf16(Bt[n][k], At[m][k], acc[ai][bj][m][n], 0, 0, 0); __builtin_amdgcn_s_setprio(0); } while (0)
#define PG8_WAIT_V(n) asm volatile("s_waitcnt vmcnt(" #n ")" ::: "memory")
#define PG8_WAIT_L(n) asm volatile("s_waitcnt lgkmcnt(" #n ")" ::: "memory")
#define PG8_BAR __builtin_amdgcn_s_barrier()
#define PG8_SCHED __builtin_amdgcn_sched_barrier(0)
    Unit cur, nxt; int ui = 0;
    if (!S.next(0, cur)) return;
    f32x4 acc[2][2][4][2];
#pragma unroll
    for (int a = 0; a < 2; ++a)
#pragma unroll
        for (int b = 0; b < 2; ++b)
#pragma unroll
            for (int m = 0; m < 4; ++m)
#pragma unroll
                for (int n = 0; n < 2; ++n) acc[a][b][m][n] = (f32x4){0.f, 0.f, 0.f, 0.f};
    bf16x8 At[4][2], B0[2][2], B1[2][2];
    const char* cA = (const char*)g.A + (size_t)cur.pm * tstep; const char* cB = (const char*)g.Bt + (size_t)cur.pn * tstep;
    S.a_ready(cur);
    if constexpr (SP2) {
        PG8_STAGE(PG8_SB(0, 0), cB, voffB); PG8_STAGE(PG8_SB(0, 1), cB + hstep, voffB); PG8_STAGE(PG8_SA(0, 0), cA, voffA); PG8_STAGE(PG8_SA(0, 1), cA + hstep, voffA);
        if (wr == 1) PG8_BAR;
        PG8_WAIT_V(2); PG8_BAR;
        PG8_STAGE(PG8_SB(1, 0), cB + kstep, voffB); PG8_STAGE(PG8_SA(1, 0), cA + kstep, voffA); PG8_STAGE(PG8_SB(1, 1), cB + hstep + kstep, voffB);
        PG8_WAIT_V(6); PG8_BAR;
    } else {
        PG8_STAGE(PG8_SB(0, 0), cB, voffB); PG8_STAGE(PG8_SA(0, 0), cA, voffA); PG8_STAGE(PG8_SB(0, 1), cB + hstep, voffB); PG8_STAGE(PG8_SA(0, 1), cA + hstep, voffA);
        if (wr == 1) PG8_BAR;
        PG8_WAIT_V(4); PG8_BAR;
        PG8_STAGE(PG8_SB(1, 0), cB + kstep, voffB); PG8_STAGE(PG8_SA(1, 0), cA + kstep, voffA); PG8_STAGE(PG8_SB(1, 1), cB + hstep + kstep, voffB);
        PG8_WAIT_V(6); PG8_BAR;
    }
    for (;;) {
        const bool has_next = S.next(ui + 1, nxt);
        const char* nA = has_next ? (const char*)g.A + (size_t)nxt.pm * tstep : cA; const char* nB = has_next ? (const char*)g.Bt + (size_t)nxt.pn * tstep : cB;
        for (int t = 0; t < nt; t += 2) {
            const bool last = (t == nt - 2);
            const char* a1 = cA + (size_t)(t + 1) * kstep;
            const char* a2 = last ? nA : cA + (size_t)(t + 2) * kstep; const char* b2 = last ? nB : cB + (size_t)(t + 2) * kstep;
            const char* a3 = a2 + kstep; const char* b3 = b2 + kstep;
            if (last && has_next) S.a_ready(nxt);
            if constexpr (SP2) {
            PG8_LDB(B0, 0, 0); PG8_LDB(B1, 0, 1); PG8_SCHED; PG8_LDA(At, 0, 0); PG8_STAGE(PG8_SA(1, 1), a1 + hstep, voffA);
            PG8_WAIT_V(8); PG8_WAIT_L(0); PG8_BAR; PG8_MMA(0, 0, At, B0); PG8_MMA(0, 1, At, B1); PG8_BAR; PG8_SCHED;
            PG8_LDA(At, 0, 1); PG8_STAGE(PG8_SB(0, 0), b2, voffB); PG8_STAGE(PG8_SB(0, 1), b2 + hstep, voffB); PG8_STAGE(PG8_SA(0, 0), a2, voffA);
            PG8_WAIT_V(8); PG8_WAIT_L(0); PG8_BAR; PG8_MMA(1, 0, At, B0); PG8_MMA(1, 1, At, B1); PG8_BAR; PG8_SCHED;
            PG8_LDB(B0, 1, 0); PG8_LDB(B1, 1, 1); PG8_SCHED; PG8_LDA(At, 1, 0); PG8_STAGE(PG8_SA(0, 1), a2 + hstep, voffA);
            PG8_WAIT_V(8); PG8_WAIT_L(0); PG8_BAR; PG8_MMA(0, 0, At, B0); PG8_MMA(0, 1, At, B1); PG8_BAR; PG8_SCHED;
            PG8_LDA(At, 1, 1); PG8_STAGE(PG8_SB(1, 0), b3, voffB); PG8_STAGE(PG8_SB(1, 1), b3 + hstep, voffB); PG8_STAGE(PG8_SA(1, 0), a3, voffA);
            PG8_WAIT_V(8); PG8_WAIT_L(0); PG8_BAR; PG8_MMA(1, 0, At, B0); PG8_MMA(1, 1, At, B1); PG8_BAR; PG8_SCHED;
            } else {
            PG8_LDB(B0, 0, 0); PG8_SCHED; PG8_LDA(At, 0, 0); PG8_STAGE(PG8_SA(1, 1), a1 + hstep, voffA);
            PG8_WAIT_L(8); PG8_BAR; PG8_WAIT_L(0); PG8_MMA(0, 0, At, B0); PG8_BAR; PG8_SCHED;
            PG8_LDB(B1, 0, 1); PG8_STAGE(PG8_SB(0, 0), b2, voffB);
            PG8_BAR; PG8_WAIT_L(0); PG8_MMA(0, 1, At, B1); PG8_BAR;
            PG8_LDA(At, 0, 1); PG8_STAGE(PG8_SA(0, 0), a2, voffA);
            PG8_BAR; PG8_WAIT_L(0); PG8_MMA(1, 0, At, B0); PG8_BAR; PG8_SCHED;
            PG8_STAGE(PG8_SB(0, 1), b2 + hstep, voffB);
            PG8_WAIT_V(6); PG8_BAR; PG8_MMA(1, 1, At, B1); PG8_BAR;
            PG8_LDB(B0, 1, 0); PG8_SCHED; PG8_LDA(At, 1, 0); PG8_STAGE(PG8_SA(0, 1), a2 + hstep, voffA);
            PG8_WAIT_L(8); PG8_BAR; PG8_WAIT_L(0); PG8_MMA(0, 0, At, B0); PG8_BAR; PG8_SCHED;
            PG8_LDB(B1, 1, 1); PG8_STAGE(PG8_SB(1, 0), b3, voffB);
            PG8_BAR; PG8_WAIT_L(0); PG8_MMA(0, 1, At, B1); PG8_BAR;
            PG8_LDA(At, 1, 1); PG8_STAGE(PG8_SA(1, 0), a3, voffA);
            PG8_BAR; PG8_WAIT_L(0); PG8_MMA(1, 0, At, B0); PG8_BAR; PG8_SCHED;
            PG8_STAGE(PG8_SB(1, 1), b3 + hstep, voffB);
            PG8_WAIT_V(6); PG8_BAR; PG8_MMA(1, 1, At, B1); PG8_BAR;
            }
        }
        if constexpr (ALIGN_EPI) { if (wr == 0) PG8_BAR; }
        if constexpr (!Epi::AFTER_DRAIN) { E(acc, cur, wr, wc, fr, fq); S.done(cur); }
        if (!has_next) break;
#pragma unroll
        for (int a = 0; a < 2; ++a)
#pragma unroll
            for (int b = 0; b < 2; ++b)
#pragma unroll
                for (int m = 0; m < 4; ++m)
#pragma unroll
                    for (int n = 0; n < 2; ++n) acc[a][b][m][n] = (f32x4){0.f, 0.f, 0.f, 0.f};
        cur = nxt; cA = nA; cB = nB; ++ui;
        if constexpr (ALIGN_EPI) { if (wr == 1) PG8_BAR; }
    }
    PG8_WAIT_V(0);
    if constexpr (!ALIGN_EPI) { if (wr == 0) PG8_BAR; }
    PG8_BAR;
    if constexpr (Epi::AFTER_DRAIN) { E.fused(acc, cur, wr, wc, fr, fq, lds, wid, lane); S.done(cur); }
#undef PG8_SA
#undef PG8_SB
#undef PG8_STAGE
#undef PG8_LDA
#undef PG8_LDB
#undef PG8_MMA
#undef PG8_WAIT_V
#undef PG8_WAIT_L
#undef PG8_BAR
#undef PG8_SCHED
}
}
#define LAS __attribute__((address_space(3)))
typedef unsigned short bf16_t;
typedef float f32x4 __attribute__((ext_vector_type(4)));
typedef unsigned u32x4 __attribute__((ext_vector_type(4)));
typedef unsigned u32x2 __attribute__((ext_vector_type(2)));
typedef short bf16x8s __attribute__((ext_vector_type(8)));
typedef float f32x16 __attribute__((ext_vector_type(16)));
#define MFMA32(a_, b_, c_) __builtin_amdgcn_mfma_f32_32x32x16_bf16((a_), (b_), (c_), 0, 0, 0)
constexpr int SEQ = 16384, TT = 32768, DM = 1024, INW = 3840, DFF = 4096, PLE = 256, DEPTH = 4;
constexpr int C_RQ = 0, C_RK = 512, C_RV = 1024, C_RG = 1536, C_SQ = 2048, C_SK = 2304, C_SV = 2560, C_Z = 2816;
constexpr size_t MiB = 1048576;
constexpr size_t WS_CTL = 0, WS_LORA = 65536, WS_ROPE = 1 * MiB, WS_WB = 5 * MiB, WS_NB = 33 * MiB, WS_PJ = 97 * MiB, WS_MX = 353 * MiB, WS_KV = 417 * MiB, WS_RWX = 449 * MiB, WS_VT = 481 * MiB, WS_HP = 497 * MiB, WS_SC = WS_WB  , WS_RSS = 507 * MiB, WS_END = 511 * MiB;
constexpr size_t WB_IN = 0, WB_O = WB_IN + (size_t)INW * DM, WB_1 = WB_O + (size_t)DM * DM, WB_2 = WB_1 + (size_t)DFF * DM, WB_PG = WB_2 + (size_t)DM * DFF, WB_PE = WB_PG + (size_t)DM * DM;
constexpr int LDS_BYTES = 147456;
constexpr int NPHASE = 46, NSUB = 11;

struct Args { const float* in[24]; float* out; unsigned char* ws; int ph_lo, ph_hi; };
typedef const __attribute__((address_space(4))) Args& ArgsR;
#define PH_FN __device__ __forceinline__

__device__ __forceinline__ int ltid() { int t = threadIdx.x; asm volatile("" : "+v"(t)); return t; }
__device__ __forceinline__ float bf2f(bf16_t v) { return __uint_as_float((unsigned)v << 16); }
__device__ __forceinline__ float bflo(unsigned w) { return __uint_as_float(w << 16); }
__device__ __forceinline__ float bfhi(unsigned w) { return __uint_as_float(w & 0xffff0000u); }
typedef __bf16 hbf16x2 __attribute__((ext_vector_type(2)));
typedef float hf32x2 __attribute__((ext_vector_type(2)));
__device__ __forceinline__ unsigned pk2(float lo, float hi) { const hf32x2 f = {lo, hi}; return __builtin_bit_cast(unsigned, __builtin_convertvector(f, hbf16x2)); }
__device__ __forceinline__ unsigned f2bf(float f) { return pk2(f, 0.f) & 0xffffu; }
__device__ __forceinline__ float wave_sum(float v) {
#pragma unroll
    for (int o = 1; o < 64; o <<= 1) v += __shfl_xor(v, o);
    return v;
}
template <int CTRL> __device__ __forceinline__ float dpp_mov(float x) { return __int_as_float(__builtin_amdgcn_update_dpp(0, __float_as_int(x), CTRL, 0xf, 0xf, false)); }
__device__ __forceinline__ float allred16(float x) { x += dpp_mov<0x128>(x); x += dpp_mov<0x124>(x); x += dpp_mov<0x122>(x); x += dpp_mov<0x121>(x); return x; }
__device__ __forceinline__ float allred4(float x) { x += dpp_mov<0xB1>(x); x += dpp_mov<0x4E>(x); return x; }
__device__ __forceinline__ float sigmoidf_(float x) { return 1.f / (1.f + __expf(-x)); }
__device__ __forceinline__ float softplusf_(float x) { return fmaxf(x, 0.f) + __logf(1.f + __expf(-fabsf(x))); }
__device__ __forceinline__ float ret_logg(int h) { return logf(1.f - exp2f(-5.f - (float)h)); }

PH_FN void ph_prologue(ArgsR a) {
    { unsigned long long* rss = (unsigned long long*)(a.ws + WS_RSS);
        for (int i = blockIdx.x * 512 + ltid(); i < 12 * TT; i += gridDim.x * 512) rss[TT + i] = 0ull;
        const int lane = ltid() & 63, wave = ltid() >> 6; bf16_t* H = (bf16_t*)(a.ws + WS_MX);
        for (int m = blockIdx.x * 8 + wave; m < TT; m += gridDim.x * 16) { const int m2 = m + gridDim.x * 8;
            const f32x4* xr = (const f32x4*)(a.in[0] + (size_t)m * DM) + lane; const f32x4* xr2 = (const f32x4*)(a.in[0] + (size_t)(m2 < TT ? m2 : m) * DM) + lane; f32x4 va[4], vb[4];
#pragma unroll
            for (int j = 0; j < 4; ++j) { va[j] = xr[64 * j]; vb[j] = xr2[64 * j]; }
            float s = 0.f, s2 = 0.f;
#pragma unroll
            for (int j = 0; j < 4; ++j) { const f32x4 v = va[j]; s += (v.x * v.x + v.y * v.y) + (v.z * v.z + v.w * v.w); u32x2 w; w.x = pk2(v.x, v.y); w.y = pk2(v.z, v.w); ((u32x2*)(H + (size_t)m * DM))[lane + 64 * j] = w; }
            if (m2 < TT) {
#pragma unroll
                for (int j = 0; j < 4; ++j) { const f32x4 v = vb[j]; s2 += (v.x * v.x + v.y * v.y) + (v.z * v.z + v.w * v.w); u32x2 w; w.x = pk2(v.x, v.y); w.y = pk2(v.z, v.w); ((u32x2*)(H + (size_t)m2 * DM))[lane + 64 * j] = w; }
                s2 = wave_sum(s2); if (lane == 0) rss[m2] = (unsigned long long)__float2ll_rn(s2 * 1048576.f); }
            s = wave_sum(s); if (lane == 0) rss[m] = (unsigned long long)__float2ll_rn(s * 1048576.f); } }
    float* cosT = (float*)(a.ws + WS_ROPE); float* sinT = cosT + SEQ * 32;
    for (int idx = blockIdx.x * 512 + ltid(); idx < SEQ * 32; idx += gridDim.x * 512) {
        const int pos = idx >> 5, i = idx & 31;
        double inv = 1.0, f = 0.7429639507594948;
#pragma unroll
        for (int bit = 0; bit < 5; ++bit) { if ((i >> bit) & 1) inv *= f; f *= f; }
        const double ang = (double)pos * inv;
        const double n = rint(ang * 0.15915494309189535);
        const float r = (float)(ang - n * 6.283185307179586);
        cosT[idx] = __cosf(r); sinT[idx] = __sinf(r);
    }
}
__device__ __forceinline__ void transpose_item(const float* W, int K, int N, bf16_t* WT, LAS float* scr, int item, int lane, const float* g = nullptr) {
    const int nblk = N / 32, kb = item / nblk, nb = item % nblk, k0 = 64 * kb, n0 = 32 * nb;
    float tv[32];
#pragma unroll
    for (int i = 0; i < 32; ++i) { const int kk = 2 * i + (lane >> 5); tv[i] = W[(size_t)(k0 + kk) * N + n0 + (lane & 31)]; }
#pragma unroll
    for (int i = 0; i < 32; ++i) { const int kk = 2 * i + (lane >> 5); scr[kk * 33 + (lane & 31)] = tv[i] * (g ? g[k0 + kk] : 1.f); }
    asm volatile("s_waitcnt lgkmcnt(0)" ::: "memory");
    const int c = lane & 7;
#pragma unroll
    for (int j = 0; j < 4; ++j) { const int n = (lane >> 3) + 8 * j; const LAS float* s = scr + (8 * c) * 33 + n;
        u32x4 o; o.x = pk2(s[0 * 33], s[1 * 33]); o.y = pk2(s[2 * 33], s[3 * 33]); o.z = pk2(s[4 * 33], s[5 * 33]); o.w = pk2(s[6 * 33], s[7 * 33]);
        *(u32x4*)(WT + (size_t)(n0 + n) * K + k0 + 8 * c) = o; }
    asm volatile("s_waitcnt lgkmcnt(0)" ::: "memory");
}
PH_FN void ph_weights(ArgsR a, int L, LAS unsigned char* lds, int part, int first, int nblk) {
    const int lane = ltid() & 63, wave = ltid() >> 6;
    LAS float* scr = (LAS float*)(lds + wave * 16384);
    bf16_t* WB = (bf16_t*)(a.ws + WS_WB);
    const int gw = first * 8 + wave, NGW = nblk * 8;
    constexpr int I_IN = (DM / 64) * (INW / 32), I_O = (DM / 64) * (DM / 32), I_1 = (DM / 64) * (DFF / 32), I_2 = (DFF / 64) * (DM / 32), I_PG = I_O, I_PE = (PLE / 64) * (DM / 32);
    constexpr int NITEMS = I_IN + I_O + I_1 + I_2 + I_PG + I_PE;
    for (int it = gw + (part == 1 ? I_IN : 0); it < (part == 0 ? I_IN : NITEMS); it += NGW) {
        int r = it;
        if (r < I_IN) { transpose_item(a.in[5] + (size_t)L * DM * INW, DM, INW, WB + WB_IN, scr, r, lane, a.in[2] + L * DM); continue; } r -= I_IN;
        if (r < I_O) { transpose_item(a.in[18] + (size_t)L * DM * DM, DM, DM, WB + WB_O, scr, r, lane); continue; } r -= I_O;
        if (r < I_1) { transpose_item(a.in[19] + (size_t)L * DM * DFF, DM, DFF, WB + WB_1, scr, r, lane, a.in[3] + L * DM); continue; } r -= I_1;
        if (r < I_2) { transpose_item(a.in[20] + (size_t)L * DFF * DM, DFF, DM, WB + WB_2, scr, r, lane); continue; } r -= I_2;
        if (r < I_PG) { transpose_item(a.in[22] + (size_t)L * DM * DM, DM, DM, WB + WB_PG, scr, r, lane, a.in[4] + L * DM); continue; } r -= I_PG;
        transpose_item(a.in[21] + (size_t)L * PLE * DM, PLE, DM, WB + WB_PE, scr, r, lane);
    }
    { bf16_t* LW = (bf16_t*)(a.ws + WS_LORA);
        for (int it = gw; it < (part == 1 ? 0 : 32); it += NGW) {
            if (it < 8) transpose_item(a.in[9] + (size_t)L * 64 * 256, 64, 256, LW, scr, it, lane);
            else if (it < 16) transpose_item(a.in[11] + (size_t)L * 64 * 256, 64, 256, LW + 256 * 64, scr, it - 8, lane);
            else transpose_item(a.in[12] + (size_t)L * 128 * 256, 128, 256, LW + 2 * 256 * 64, scr, it - 16, lane); } }
}
PH_FN void ph_final(const unsigned long long* rss, const float* g, float* dst) {
    const int lane = ltid() & 63, wave = ltid() >> 6;
    f32x4 gg[4];
#pragma unroll
    for (int j = 0; j < 4; ++j) gg[j] = ((const f32x4*)g)[lane + 64 * j];
    for (int m = blockIdx.x * 8 + wave; m < TT; m += gridDim.x * 16) { const int m2 = (m + gridDim.x * 8 < TT) ? m + gridDim.x * 8 : m;
        const float rs = rsqrtf((float)rss[m] * (1.f / (1024.f * 1048576.f)) + 1e-6f), rs2 = rsqrtf((float)rss[m2] * (1.f / (1024.f * 1048576.f)) + 1e-6f);
        f32x4* row = (f32x4*)(dst + (size_t)m * DM); f32x4* row2 = (f32x4*)(dst + (size_t)m2 * DM); f32x4 va[4], vb[4];
#pragma unroll
        for (int j = 0; j < 4; ++j) { va[j] = row[lane + 64 * j]; vb[j] = row2[lane + 64 * j]; }
#pragma unroll
        for (int j = 0; j < 4; ++j) row[lane + 64 * j] = va[j] * rs * gg[j];
        if (m2 != m) {
#pragma unroll
            for (int j = 0; j < 4; ++j) row2[lane + 64 * j] = vb[j] * rs2 * gg[j]; } }
}
PH_FN void ph_pconv(const float* p, bf16_t* dst) {
    const size_t n4 = (size_t)TT * PLE / 4, stride = (size_t)gridDim.x * 512;
    size_t i = (size_t)blockIdx.x * 512 + ltid();
    for (; i + 7 * stride < n4; i += 8 * stride) { f32x4 v[8];
#pragma unroll
        for (int q = 0; q < 8; ++q) v[q] = ((const f32x4*)p)[i + q * stride];
#pragma unroll
        for (int q = 0; q < 8; ++q) { u32x2 w; w.x = pk2(v[q].x, v[q].y); w.y = pk2(v[q].z, v[q].w); ((u32x2*)dst)[i + q * stride] = w; } }
    for (; i < n4; i += stride) { const f32x4 v = ((const f32x4*)p)[i]; u32x2 w; w.x = pk2(v.x, v.y); w.y = pk2(v.z, v.w); ((u32x2*)dst)[i] = w; }
}
__device__ __forceinline__ f32x4 bf4(u32x2 w) { return (f32x4){bflo(w.x), bfhi(w.x), bflo(w.y), bfhi(w.y)}; }
PH_FN void ph_rwkv_prep(ArgsR a, int L, LAS unsigned char* lds) {
    constexpr int ZB_LD = 264, OB_LD = 776;
    LAS bf16_t* zb = (LAS bf16_t*)lds;
    LAS bf16_t* ob = zb + 64 * ZB_LD;
    LAS float* zl = (LAS float*)(ob + 64 * OB_LD);
    const int tid = ltid(), lane = tid & 63, wave = tid >> 6, cq = tid & 63, tg = tid >> 6, c4 = 4 * cq;
    const bf16_t* PJ = (const bf16_t*)(a.ws + WS_PJ);
    bf16_t* RW_R = (bf16_t*)(a.ws + WS_NB); bf16_t* RW_KM = RW_R + (size_t)TT * 256; bf16_t* RW_V = RW_KM + (size_t)TT * 256; bf16_t* RW_KK = RW_V + (size_t)TT * 256;
    bf16_t* RW_LD = (bf16_t*)(a.ws + WS_RWX); bf16_t* RW_B = (bf16_t*)(a.ws + WS_RWX + 16 * MiB); bf16_t* RW_G = (bf16_t*)(a.ws + WS_PJ + 240 * MiB); bf16_t* VT = (bf16_t*)(a.ws + WS_VT);
    unsigned* kmax = (unsigned*)(a.ws + WS_CTL) + 64 + L * 8;
    const float* mu = a.in[7] + L * 1024; const float* w0 = a.in[8] + L * 256; const float* w_up = a.in[9] + L * 64 * 256; const float* a0 = a.in[10] + L * 256;
    const float* a_up = a.in[11] + L * 64 * 256; const float* g_up = a.in[12] + L * 128 * 256; const float* k_k = a.in[13] + L * 256; const float* k_a = a.in[14] + L * 256;
    float mxl0 = 0.f, mxl1 = 0.f;
    for (int u = blockIdx.x; u < TT / 64; u += gridDim.x) {
        const int tok0 = u * 64;
        for (int v8 = tid; v8 < 64 * 32; v8 += 512) { const int t = v8 >> 5, c8 = (v8 & 31) * 8, tok = tok0 + t;
            const u32x4 zc = *(const u32x4*)(PJ + (size_t)tok * INW + C_Z + 768 + c8);
            u32x4 zp = (u32x4){0u, 0u, 0u, 0u}; if ((tok & (SEQ - 1)) != 0) zp = *(const u32x4*)(PJ + (size_t)(tok - 1) * INW + C_Z + 768 + c8);
            const float zv[8] = {bflo(zc.x), bfhi(zc.x), bflo(zc.y), bfhi(zc.y), bflo(zc.z), bfhi(zc.z), bflo(zc.w), bfhi(zc.w)};
            const float pv[8] = {bflo(zp.x), bfhi(zp.x), bflo(zp.y), bfhi(zp.y), bflo(zp.z), bfhi(zp.z), bflo(zp.w), bfhi(zp.w)};
            const f32x4 m0 = *(const f32x4*)(mu + 768 + c8), m1 = *(const f32x4*)(mu + 768 + c8 + 4); const float mv[8] = {m0.x, m0.y, m0.z, m0.w, m1.x, m1.y, m1.z, m1.w};
            float o[8];
#pragma unroll
            for (int q = 0; q < 8; ++q) { float val = zv[q] + mv[q] * (pv[q] - zv[q]);
                if (c8 < 64) val = 1.f - 2.f / (1.f + __expf(2.f * val)); else if (c8 >= 128) val = sigmoidf_(val);
                o[q] = val; }
            *(LAS u32x4*)(zb + t * ZB_LD + c8) = (u32x4){pk2(o[0], o[1]), pk2(o[2], o[3]), pk2(o[4], o[5]), pk2(o[6], o[7])}; }
        asm volatile("" ::: "memory");
        __syncthreads();
        { const int r_ = lane & 31, hh_ = lane >> 5; const bf16_t* LW = (const bf16_t*)(a.ws + WS_LORA);
#pragma unroll
            for (int pr = 0; pr < 3; ++pr) {
                const int nk = (pr == 2) ? 8 : 4, zo = (pr == 0) ? 0 : (pr == 1) ? 64 : 128; const bf16_t* wp = LW + (pr == 0 ? 0 : pr == 1 ? 256 * 64 : 2 * 256 * 64) + (size_t)(32 * wave + r_) * (16 * nk) + 8 * hh_;
                bf16x8s bfr[8];
#pragma unroll
                for (int ks = 0; ks < 8; ++ks) if (ks < nk) bfr[ks] = __builtin_bit_cast(bf16x8s, *(const u32x4*)(wp + 16 * ks));
#pragma unroll
                for (int tb = 0; tb < 2; ++tb) { f32x16 x;
#pragma unroll
                    for (int i = 0; i < 16; ++i) x[i] = 0.f;
                    const LAS bf16_t* ar = zb + (32 * tb + r_) * ZB_LD + 8 * hh_ + zo;
#pragma unroll
                    for (int ks = 0; ks < 8; ++ks) if (ks < nk) x = MFMA32(__builtin_bit_cast(bf16x8s, *(const LAS u32x4*)(ar + 16 * ks)), bfr[ks], x);
#pragma unroll
                    for (int i = 0; i < 16; ++i) ob[(32 * tb + (i & 3) + 8 * (i >> 2) + 4 * hh_) * OB_LD + 256 * pr + 32 * wave + r_] = (bf16_t)f2bf(x[i]); } } }
        asm volatile("" ::: "memory");
        __syncthreads();
        const f32x4 w0v = *(const f32x4*)(w0 + c4), a0v = *(const f32x4*)(a0 + c4);
        { const f32x4 kkc = *(const f32x4*)(k_k + c4), kac = *(const f32x4*)(k_a + c4), mr = *(const f32x4*)(mu + c4), mk = *(const f32x4*)(mu + 256 + c4), mvv = *(const f32x4*)(mu + 512 + c4);
#pragma unroll 1
            for (int tb4 = 0; tb4 < 2; ++tb4) {
              u32x2 lr[4], lk[4], lv[4], lrp[4], lkp[4], lvp[4];
#pragma unroll
              for (int t4 = 0; t4 < 4; ++t4) { const int tok = tok0 + 8 * tg + 4 * tb4 + t4; const bf16_t* zr = PJ + (size_t)tok * INW + C_Z + c4; const bool first = (tok & (SEQ - 1)) == 0;
                lr[t4] = *(const u32x2*)(zr); lk[t4] = *(const u32x2*)(zr + 256); lv[t4] = *(const u32x2*)(zr + 512);
                lrp[t4] = (u32x2){0u, 0u}; lkp[t4] = lrp[t4]; lvp[t4] = lrp[t4];
                if (!first) { lrp[t4] = *(const u32x2*)(zr - INW); lkp[t4] = *(const u32x2*)(zr - INW + 256); lvp[t4] = *(const u32x2*)(zr - INW + 512); } }
#pragma unroll
              for (int t4 = 0; t4 < 4; ++t4) { const int t = 4 * tb4 + t4; const int tok = tok0 + 8 * tg + t; const size_t idx = (size_t)tok * 256 + c4;
                const f32x4 rc = bf4(lr[t4]), kc = bf4(lk[t4]), vc = bf4(lv[t4]), rp = bf4(lrp[t4]), kp = bf4(lkp[t4]), vp = bf4(lvp[t4]);
                const f32x4 r = rc + mr * (rp - rc), k = kc + mk * (kp - kc), v = vc + mvv * (vp - vc);
                f32x4 ld, as, kk, km, bb;
                const LAS bf16_t* orow = ob + (8 * tg + t) * OB_LD + c4; const f32x4 lwv = bf4(*(const LAS u32x2*)orow) + w0v, aav = bf4(*(const LAS u32x2*)(orow + 256)) + a0v, ggv = bf4(*(const LAS u32x2*)(orow + 512));
#pragma unroll
                for (int q = 0; q < 4; ++q) { const float logw = -softplusf_(-lwv[q]) - 0.5f; ld[q] = -__expf(logw); as[q] = sigmoidf_(aav[q]); }
                kk = k * kkc; const float n2 = allred16((kk.x * kk.x + kk.y * kk.y) + (kk.z * kk.z + kk.w * kk.w)); kk = kk * (1.f / fmaxf(sqrtf(n2), 1e-12f));
                km = k * (1.f + (as - 1.f) * kac); bb = kk * as;
                *(u32x2*)(RW_R + idx) = (u32x2){pk2(r.x, r.y), pk2(r.z, r.w)}; *(u32x2*)(RW_KM + idx) = (u32x2){pk2(km.x, km.y), pk2(km.z, km.w)}; *(u32x2*)(RW_V + idx) = (u32x2){pk2(v.x, v.y), pk2(v.z, v.w)};
                *(u32x2*)(RW_KK + idx) = (u32x2){pk2(kk.x, kk.y), pk2(kk.z, kk.w)}; *(u32x2*)(RW_B + idx) = (u32x2){pk2(bb.x, bb.y), pk2(bb.z, bb.w)}; *(u32x2*)(RW_LD + idx) = (u32x2){pk2(ld.x, ld.y), pk2(ld.z, ld.w)};
                *(u32x2*)(RW_G + idx) = (u32x2){pk2(ggv.x, ggv.y), pk2(ggv.z, ggv.w)}; } } }
        { const int b = tok0 / SEQ; float n2m = 0.f;
#pragma unroll
            for (int tt = 0; tt < 8; ++tt) { const f32x4 kv = bf4(*(const u32x2*)(PJ + (size_t)(tok0 + 8 * wave + tt) * INW + C_SK + 4 * lane));
                n2m = fmaxf(n2m, allred16((kv.x * kv.x + kv.y * kv.y) + (kv.z * kv.z + kv.w * kv.w))); }
            if (b == 0) mxl0 = fmaxf(mxl0, n2m); else mxl1 = fmaxf(mxl1, n2m); }
        { const int col = tid & 255, b = tok0 / SEQ; unsigned short e[4][8];
#pragma unroll
            for (int it = 0; it < 4; ++it) { const int th = (tid >> 8) + 2 * it;
#pragma unroll
                for (int t = 0; t < 8; ++t) e[it][t] = PJ[(size_t)(tok0 + th * 8 + t) * INW + C_SV + col]; }
#pragma unroll
            for (int it = 0; it < 4; ++it) { const int th = (tid >> 8) + 2 * it, s0 = (tok0 & (SEQ - 1)) + th * 8;
                u32x4 o; o.x = e[it][0] | ((unsigned)e[it][1] << 16); o.y = e[it][2] | ((unsigned)e[it][3] << 16); o.z = e[it][4] | ((unsigned)e[it][5] << 16); o.w = e[it][6] | ((unsigned)e[it][7] << 16);
                *(u32x4*)(VT + ((size_t)((b * 4 + (col >> 6)) * 64 + (col & 63))) * SEQ + s0) = o; } }
        __syncthreads();
    }
    if ((lane & 15) == 0) { zl[wave * 8 + (lane >> 4)] = mxl0; zl[wave * 8 + 4 + (lane >> 4)] = mxl1; }
    __syncthreads();
    if (tid < 8) { float m = 0.f;
#pragma unroll
        for (int w_ = 0; w_ < 8; ++w_) m = fmaxf(m, zl[w_ * 8 + tid]);
        atomicMax(kmax + tid, __float_as_uint(m)); }
    __syncthreads();
}
typedef float f32x2 __attribute__((ext_vector_type(2)));
constexpr int SC_NC = 32, SC_LEN = SEQ / SC_NC;
struct ScOps { f32x4 r, w, km, kk, b, vv; };
template <int NR> __device__ __forceinline__ ScOps sc_ld(const LAS float* p, int j4, int rowA) { ScOps o; o.r = *(const LAS f32x4*)(p + j4); o.w = *(const LAS f32x4*)(p + 64 + j4); o.km = *(const LAS f32x4*)(p + 128 + j4);
    o.kk = *(const LAS f32x4*)(p + 192 + j4); o.b = *(const LAS f32x4*)(p + 256 + j4);
    if (NR == 4) o.vv = *(const LAS f32x4*)(p + 320 + rowA); else { const f32x2 v2 = *(const LAS f32x2*)(p + 320 + rowA); o.vv = (f32x4){v2.x, v2.y, 0.f, 0.f}; } return o; }
template <int NR, bool REAL, bool YOUT> __device__ __forceinline__ void sc_step(const ScOps& o, f32x2 (&S)[4][2], LAS float* yp) {
    const f32x2 kk01 = o.kk.xy, kk23 = o.kk.zw, w01 = o.w.xy, w23 = o.w.zw, bb01 = o.b.xy, bb23 = o.b.zw, km01 = o.km.xy, km23 = o.km.zw;
    float sa[4];
#pragma unroll
    for (int c = 0; c < NR; ++c) { const f32x2 pa = S[c][0] * kk01 + S[c][1] * kk23; sa[c] = -allred16(pa.x + pa.y); }
#pragma unroll
    for (int c = 0; c < NR; ++c) { f32x2 t01 = bb01 * sa[c], t23 = bb23 * sa[c];
        if (REAL) { t01 += km01 * o.vv[c]; t23 += km23 * o.vv[c]; }
        S[c][0] = S[c][0] * w01 + t01; S[c][1] = S[c][1] * w23 + t23; }
    if (YOUT) { const f32x2 r01 = o.r.xy, r23 = o.r.zw; f32x4 y = {0.f, 0.f, 0.f, 0.f};
#pragma unroll
        for (int c = 0; c < NR; ++c) { const f32x2 q = S[c][0] * r01 + S[c][1] * r23; y[c] = allred16(q.x + q.y); }
        if (NR == 4) *(LAS f32x4*)yp = y; else *(LAS f32x2*)yp = y.xy; }
}
template <int NR, bool REAL, bool YOUT> __device__ __forceinline__ void sc_chunk(const LAS float* bb, int j4, int rowA, f32x2 (&S)[4][2], LAS float* yb) {
    ScOps oa = sc_ld<NR>(bb, j4, rowA);
#pragma unroll 2
    for (int s = 0; s < 32; s += 2) {
        const ScOps ob = sc_ld<NR>(bb + (s + 1) * 384, j4, rowA);
        sc_step<NR, REAL, YOUT>(oa, S, yb + s * 64 + rowA);
        oa = sc_ld<NR>(bb + (s + 2) * 384, j4, rowA);
        sc_step<NR, REAL, YOUT>(ob, S, yb + (s + 1) * 64 + rowA);
    }
}
template <int PASS> PH_FN void ph_scan_pass(ArgsR a, LAS unsigned char* lds, int unit, int L) {
    const int tid = ltid(), lane = tid & 63, wave = tid >> 6, rg = lane >> 4, j = lane & 15, j4 = 4 * j;
    int bh, c; const int kind = (PASS == 1) ? (wave >> 2) : 0;
    if (PASS == 1) { bh = unit / (SC_NC - 1); c = unit % (SC_NC - 1); } else { bh = unit / SC_NC; c = unit % SC_NC; }
    const int b = bh >> 2, h = bh & 3, t0 = c * SC_LEN;
    constexpr int NR = (PASS == 1) ? 4 : 2;
    const int rowA = (PASS == 1) ? (wave & 3) * 16 + 4 * rg : wave * 8 + 2 * rg;
    const bool active = true;
    const bf16_t* RW_R = (const bf16_t*)(a.ws + WS_NB); const bf16_t* RW_KM = RW_R + (size_t)TT * 256; const bf16_t* RW_V = RW_KM + (size_t)TT * 256; const bf16_t* RW_KK = RW_V + (size_t)TT * 256;
    const bf16_t* RW_LD = (const bf16_t*)(a.ws + WS_RWX); const bf16_t* RW_B = (const bf16_t*)(a.ws + WS_RWX + 16 * MiB);
    float* HP = (float*)(a.ws + WS_HP); const float* SC = (const float*)(a.ws + WS_SC);
    bf16_t* MX = (bf16_t*)(a.ws + WS_MX);
    LAS float* buf0 = (LAS float*)lds; LAS float* ybuf = buf0 + 2 * 32 * 384;
    const int st = tid >> 4, c4 = (tid & 15) * 4;
    const size_t gbase = ((size_t)b * SEQ + t0) * 256 + h * 64 + c4;
    u32x2 pr, pkm, pkk, pb, pv, pw;
#define SC_LOAD(ch) do { const size_t g_ = gbase + (size_t)((ch) * 32 + st) * 256; pr = *(const u32x2*)(RW_R + g_); pkm = *(const u32x2*)(RW_KM + g_); pkk = *(const u32x2*)(RW_KK + g_); \
        pb = *(const u32x2*)(RW_B + g_); pv = *(const u32x2*)(RW_V + g_); pw = *(const u32x2*)(RW_LD + g_); } while (0)
#define SC_UNP(w) ((f32x4){bflo((w).x), bfhi((w).x), bflo((w).y), bfhi((w).y)})
#define SC_STORE(bufi) do { LAS float* d_ = buf0 + (bufi) * (32 * 384) + st * 384 + c4; *(LAS f32x4*)(d_) = SC_UNP(pr); { const f32x4 l_ = SC_UNP(pw); *(LAS f32x4*)(d_ + 64) = (f32x4){__expf(l_.x), __expf(l_.y), __expf(l_.z), __expf(l_.w)}; } *(LAS f32x4*)(d_ + 128) = SC_UNP(pkm); \
        *(LAS f32x4*)(d_ + 192) = SC_UNP(pkk); *(LAS f32x4*)(d_ + 256) = SC_UNP(pb); *(LAS f32x4*)(d_ + 320) = SC_UNP(pv); } while (0)
    const int fs_ = tid >> 4, fr4_ = (tid & 15) * 4; const bf16_t* RW_G = (const bf16_t*)(a.ws + WS_PJ + 240 * MiB);
    f32x4 rk4 = {0.f, 0.f, 0.f, 0.f}, lw4 = rk4, lb4 = rk4; u32x2 fr_ = {0u, 0u}, fkm_ = fr_, fv_ = fr_, fg_ = fr_;
    if (PASS == 2) { rk4 = *(const f32x4*)(a.in[15] + L * 256 + h * 64 + fr4_); lw4 = *(const f32x4*)(a.in[16] + L * 256 + h * 64 + fr4_); lb4 = *(const f32x4*)(a.in[17] + L * 256 + h * 64 + fr4_); }
#define SC_FPRE(chp) do { const size_t i_ = ((size_t)b * SEQ + t0 + (chp) * 32 + fs_) * 256 + h * 64 + fr4_; fr_ = *(const u32x2*)(RW_R + i_); fkm_ = *(const u32x2*)(RW_KM + i_); fv_ = *(const u32x2*)(RW_V + i_); fg_ = *(const u32x2*)(RW_G + i_); } while (0)
#define SC_FLUSH(chp) do { const f32x4 y_ = *(const LAS f32x4*)(ybuf + ((chp) & 1) * 2048 + fs_ * 64 + fr4_); const f32x4 r_ = bf4(fr_), km_ = bf4(fkm_), v_ = bf4(fv_), g_ = bf4(fg_); \
        const float mean_ = allred16((y_.x + y_.y) + (y_.z + y_.w)) * (1.f / 64.f); const f32x4 d_ = y_ - mean_; const float var_ = allred16((d_.x * d_.x + d_.y * d_.y) + (d_.z * d_.z + d_.w * d_.w)) * (1.f / 64.f); \
        const f32x4 t_ = r_ * km_ * rk4; const float bon_ = allred16((t_.x + t_.y) + (t_.z + t_.w)); const f32x4 o_ = (d_ * rsqrtf(var_ + 64e-5f) * lw4 + lb4 + v_ * bon_) * g_; \
        *(u32x2*)(MX + ((size_t)b * SEQ + t0 + (chp) * 32 + fs_) * 1024 + 768 + h * 64 + fr4_) = (u32x2){pk2(o_.x, o_.y), pk2(o_.z, o_.w)}; } while (0)
    f32x2 S[4][2];
#pragma unroll
    for (int q = 0; q < 4; ++q) { S[q][0] = (f32x2){0.f, 0.f}; S[q][1] = (f32x2){0.f, 0.f}; }
    if (PASS == 1) { if (kind == 1) {
#pragma unroll
            for (int q = 0; q < 4; ++q) { S[q][0].x = (j4 == rowA + q) ? 1.f : 0.f; S[q][0].y = (j4 + 1 == rowA + q) ? 1.f : 0.f; S[q][1].x = (j4 + 2 == rowA + q) ? 1.f : 0.f; S[q][1].y = (j4 + 3 == rowA + q) ? 1.f : 0.f; } } }
    else if (c > 0) { const float* sp = SC + ((size_t)(bh * SC_NC + c)) * 4096;
#pragma unroll
        for (int q = 0; q < NR; ++q) { const f32x4 sv = *(const f32x4*)(sp + (rowA + q) * 64 + j4); S[q][0] = sv.xy; S[q][1] = sv.zw; } }
    SC_LOAD(0); SC_STORE(0); __syncthreads();
    constexpr int NRC = SC_LEN / 32;
    for (int ch = 0; ch < NRC; ++ch) {
        if (ch + 1 < NRC) SC_LOAD(ch + 1);
        if (PASS == 2 && ch > 0) SC_FLUSH(ch - 1);
        if (PASS == 2) SC_FPRE(ch);
        const LAS float* bb = buf0 + (ch & 1) * (32 * 384); LAS float* yb = ybuf + (ch & 1) * 2048;
        if (active) {
            if (PASS == 2) sc_chunk<2, true, true>(bb, j4, rowA, S, yb);
            else if (kind == 0) sc_chunk<4, true, false>(bb, j4, rowA, S, yb);
            else sc_chunk<4, false, false>(bb, j4, rowA, S, yb);
        }
        if (ch + 1 < NRC) SC_STORE((ch + 1) & 1);
        __syncthreads();
    }
    if (PASS == 2) SC_FLUSH(NRC - 1);
    else { float* hp = HP + ((size_t)((bh * (SC_NC - 1) + c) * 2 + kind)) * 4096;
#pragma unroll
        for (int q = 0; q < 4; ++q) *(f32x4*)(hp + (rowA + q) * 64 + j4) = (f32x4){S[q][0].x, S[q][0].y, S[q][1].x, S[q][1].y}; }
    __syncthreads();
#undef SC_LOAD
#undef SC_UNP
#undef SC_STORE
#undef SC_FLUSH
#undef SC_FPRE
}
PH_FN void ph_scan_combine(ArgsR a, LAS unsigned char* lds, int unit) {
    LAS float* Ss = (LAS float*)lds; LAS float* Ps = Ss + 16 * 64;
    const float* HP = (const float*)(a.ws + WS_HP); float* SC = (float*)(a.ws + WS_SC);
    const int bh = unit >> 2, v0 = (unit & 3) * 16;
    const int tid = ltid(), v = tid >> 5, k2 = (tid & 31) * 2;
    float s0 = 0.f, s1 = 0.f;
    const float* Hc = HP + ((size_t)(bh * (SC_NC - 1) * 2)) * 4096;
    f32x4 p0 = *(const f32x4*)(Hc + 4096 + tid * 8), p1 = *(const f32x4*)(Hc + 4096 + tid * 8 + 4); f32x2 hv = *(const f32x2*)(Hc + (v0 + v) * 64 + k2);
    for (int c = 0; c < SC_NC - 1; ++c) {
        *(LAS f32x4*)(Ps + tid * 8) = p0; *(LAS f32x4*)(Ps + tid * 8 + 4) = p1; *(LAS f32x2*)(Ss + v * 64 + k2) = (f32x2){s0, s1};
        float n0 = hv.x, n1 = hv.y;
        if (c + 1 < SC_NC - 1) { const float* Hn = Hc + (size_t)(c + 1) * 8192; p0 = *(const f32x4*)(Hn + 4096 + tid * 8); p1 = *(const f32x4*)(Hn + 4096 + tid * 8 + 4); hv = *(const f32x2*)(Hn + (v0 + v) * 64 + k2); }
        __syncthreads();
#pragma unroll 8
        for (int m = 0; m < 64; ++m) { const float sv = Ss[v * 64 + m]; const f32x2 q = *(const LAS f32x2*)(Ps + m * 64 + k2); n0 += sv * q.x; n1 += sv * q.y; }
        s0 = n0; s1 = n1;
        *(f32x2*)(SC + ((size_t)(bh * SC_NC + c + 1)) * 4096 + (v0 + v) * 64 + k2) = (f32x2){s0, s1};
        __syncthreads();
    }
}
PH_FN void ph_ret_scan(ArgsR a, int u) {
    bf16_t* KV = (bf16_t*)(a.ws + WS_KV);
    const int e2 = u * 512 + ltid();
    const int bh = e2 >> 11, within = (e2 & 2047) * 2, h = bh & 7;
    const float g64 = __expf(64.f * ret_logg(h));
    bf16_t* p = KV + (size_t)bh * 256 * 4096 + within;
    float s0 = 0.f, s1 = 0.f;
    for (int c0 = 0; c0 < 256; c0 += 32) { unsigned x[32];
#pragma unroll
        for (int q = 0; q < 32; ++q) x[q] = *(const unsigned*)(p + (size_t)(c0 + q) * 4096);
#pragma unroll
        for (int q = 0; q < 32; ++q) { *(unsigned*)(p + (size_t)(c0 + q) * 4096) = pk2(s0, s1); s0 = s0 * g64 + bflo(x[q]); s1 = s1 * g64 + bfhi(x[q]); } }
}
__device__ __forceinline__ bf16x8s sb_pack8(float w0, float w1, float w2, float w3, float w4, float w5, float w6, float w7) {
    u32x4 pk; pk.x = pk2(w0, w1); pk.y = pk2(w2, w3); pk.z = pk2(w4, w5); pk.w = pk2(w6, w7); return __builtin_bit_cast(bf16x8s, pk); }
__device__ __forceinline__ float sb_pairsum(float x) { const unsigned xi = __float_as_uint(x); const auto rr = __builtin_amdgcn_permlane32_swap(xi, xi, false, false); return __uint_as_float(rr[0]) + __uint_as_float(rr[1]); }
PH_FN void ph_sb(ArgsR a, int L, int first, int nblk) {
    const bf16_t* PJ = (const bf16_t*)(a.ws + WS_PJ); const bf16_t* VT = (const bf16_t*)(a.ws + WS_VT); bf16_t* MX = (bf16_t*)(a.ws + WS_MX);
    const unsigned* kmax = (const unsigned*)(a.ws + WS_CTL) + 64 + L * 8;
    const int tid = ltid(), lane = tid & 63, wave = tid >> 6, r = lane & 31, hh = lane >> 5;
    for (int u = first; u < 512; u += nblk) {
        const int bh = u & 7, qi = (63 - (u >> 3)) * 8 + wave, b = bh >> 2, h = bh & 3, q0 = qi * 32;
        bf16x8s bq[4]; float qn2 = 0.f;
        { const bf16_t* qp = PJ + ((size_t)b * SEQ + q0 + r) * INW + C_SQ + h * 64 + 8 * hh;
#pragma unroll
            for (int ks = 0; ks < 4; ++ks) { const u32x4 w = *(const u32x4*)(qp + 16 * ks); bq[ks] = __builtin_bit_cast(bf16x8s, w);
                qn2 += bflo(w.x) * bflo(w.x) + bfhi(w.x) * bfhi(w.x) + bflo(w.y) * bflo(w.y) + bfhi(w.y) * bfhi(w.y) + bflo(w.z) * bflo(w.z) + bfhi(w.z) * bfhi(w.z) + bflo(w.w) * bflo(w.w) + bfhi(w.w) * bfhi(w.w); } }
        qn2 = sb_pairsum(qn2);
        const float bound = sqrtf(qn2) * 0.125f * sqrtf(__uint_as_float(kmax[bh])) * 1.001f + 1e-3f;
        f32x16 o0, o1;
#pragma unroll
        for (int i = 0; i < 16; ++i) { o0[i] = 0.f; o1[i] = 0.f; }
        float after = 0.f;
        u32x4 nk_[4]; u32x2 nlo[2][2], nhi[2][2];
#define SB_LOADT(k0_) do { const int kc_ = (k0_) >= 0 ? (k0_) : 0; const bf16_t* kp_ = PJ + ((size_t)b * SEQ + kc_ + r) * INW + C_SK + h * 64 + 8 * hh; \
            _Pragma("unroll") for (int ks = 0; ks < 4; ++ks) nk_[ks] = *(const u32x4*)(kp_ + 16 * ks); \
            const bf16_t* vt_ = VT + ((size_t)(bh * 64 + r)) * SEQ + kc_ + 4 * hh; \
            _Pragma("unroll") for (int s = 0; s < 2; ++s) _Pragma("unroll") for (int dh = 0; dh < 2; ++dh) { nlo[s][dh] = *(const u32x2*)(vt_ + (size_t)dh * 32 * SEQ + 16 * s); nhi[s][dh] = *(const u32x2*)(vt_ + (size_t)dh * 32 * SEQ + 16 * s + 8); } } while (0)
        SB_LOADT(q0);
        for (int k0 = q0; k0 >= 0; k0 -= 32) {
            bf16x8s ak[4], pb[2][2];
#pragma unroll
            for (int ks = 0; ks < 4; ++ks) ak[ks] = __builtin_bit_cast(bf16x8s, nk_[ks]);
#pragma unroll
            for (int s = 0; s < 2; ++s)
#pragma unroll
                for (int dh = 0; dh < 2; ++dh) pb[s][dh] = __builtin_bit_cast(bf16x8s, (u32x4){nlo[s][dh].x, nlo[s][dh].y, nhi[s][dh].x, nhi[s][dh].y});
            SB_LOADT(k0 - 32);
            f32x16 x;
#pragma unroll
            for (int i = 0; i < 16; ++i) x[i] = 0.f;
#pragma unroll
            for (int ks = 0; ks < 4; ++ks) x = MFMA32(ak[ks], bq[ks], x);
            const bool diag = (k0 == q0);
            float z[16], ls[16], w[16];
#pragma unroll
            for (int i = 0; i < 16; ++i) { z[i] = x[i] * 0.125f; const bool valid = !diag || (((i & 3) + 8 * (i >> 2) + 4 * hh) < r); ls[i] = valid ? -softplusf_(z[i]) : 0.f; }
            float acc = after;
#pragma unroll
            for (int g = 3; g >= 0; --g) { const float G = (ls[4 * g] + ls[4 * g + 1]) + (ls[4 * g + 2] + ls[4 * g + 3]); const float tot = sb_pairsum(G);
                const float base = acc + (hh == 0 ? tot - G : 0.f);
                const float c3 = base + ls[4 * g + 3], c2 = c3 + ls[4 * g + 2], c1 = c2 + ls[4 * g + 1], c0 = c1 + ls[4 * g];
                w[4 * g + 3] = __expf(z[4 * g + 3] + c3); w[4 * g + 2] = __expf(z[4 * g + 2] + c2); w[4 * g + 1] = __expf(z[4 * g + 1] + c1); w[4 * g] = __expf(z[4 * g] + c0);
                acc += tot; }
            after = acc;
            if (diag) {
#pragma unroll
                for (int i = 0; i < 16; ++i) if (!(((i & 3) + 8 * (i >> 2) + 4 * hh) < r)) w[i] = 0.f; }
            const bf16x8s xs0 = sb_pack8(w[0], w[1], w[2], w[3], w[4], w[5], w[6], w[7]), xs1 = sb_pack8(w[8], w[9], w[10], w[11], w[12], w[13], w[14], w[15]);
            o0 = MFMA32(xs0, pb[0][0], o0); o0 = MFMA32(xs1, pb[1][0], o0); o1 = MFMA32(xs0, pb[0][1], o1); o1 = MFMA32(xs1, pb[1][1], o1);
            if (__all((after + bound < -104.f) ? 1 : 0)) break;
        }
        bf16_t* op = MX + ((size_t)b * SEQ + q0) * 1024 + 512 + h * 64 + r;
#pragma unroll
        for (int i = 0; i < 16; ++i) { const int qr = (i & 3) + 8 * (i >> 2) + 4 * hh; op[(size_t)qr * 1024] = (bf16_t)f2bf(o0[i]); op[(size_t)qr * 1024 + 32] = (bf16_t)f2bf(o1[i]); }
    }
}
__device__ __forceinline__ void rk_unp8(u32x4 w, float (&f)[8]) { f[0] = bflo(w.x); f[1] = bfhi(w.x); f[2] = bflo(w.y); f[3] = bfhi(w.y); f[4] = bflo(w.z); f[5] = bfhi(w.z); f[6] = bflo(w.w); f[7] = bfhi(w.w); }
PH_FN void ph_ret_kv(ArgsR a, LAS unsigned char* lds) {
    bf16_t* PJ = (bf16_t*)(a.ws + WS_PJ); bf16_t* KV = (bf16_t*)(a.ws + WS_KV);
    const float* cosT = (const float*)(a.ws + WS_ROPE); const float* sinT = cosT + SEQ * 32;
    const int tid = ltid(), lane = tid & 63, wave = tid >> 6, r = lane & 31, hh = lane >> 5;
    LAS bf16_t* kdt = (LAS bf16_t*)(lds + wave * 17408); LAS bf16_t* vtl = kdt + 64 * 68;
    for (int cu = blockIdx.x * 8 + wave; cu < 4096; cu += gridDim.x * 8) {
        const int b = cu >> 11, c = (cu >> 3) & 255, h = cu & 7, tok0 = b * SEQ + c * 64;
        const float lg = ret_logg(h), dk = __expf((float)(63 - lane) * lg);
        bf16_t* qp = PJ + (size_t)(tok0 + lane) * INW + C_RQ + h * 64; bf16_t* kp = PJ + (size_t)(tok0 + lane) * INW + C_RK + h * 64; const bf16_t* vp = PJ + (size_t)(tok0 + lane) * INW + C_RV + h * 64;
        const float* cp = cosT + (size_t)(c * 64 + lane) * 32; const float* sp = sinT + (size_t)(c * 64 + lane) * 32;
        f32x4 c0a[4], c1a[4], s0a[4], s1a[4]; u32x4 kla[4], kha[4], qla[4], qha[4];
#pragma unroll
        for (int g = 0; g < 4; ++g) { c0a[g] = *(const f32x4*)(cp + 8 * g); c1a[g] = *(const f32x4*)(cp + 8 * g + 4); s0a[g] = *(const f32x4*)(sp + 8 * g); s1a[g] = *(const f32x4*)(sp + 8 * g + 4);
            kla[g] = *(const u32x4*)(kp + 8 * g); kha[g] = *(const u32x4*)(kp + 32 + 8 * g); qla[g] = *(const u32x4*)(qp + 8 * g); qha[g] = *(const u32x4*)(qp + 32 + 8 * g); }
        u32x4 vra[8];
#pragma unroll
        for (int q = 0; q < 8; ++q) vra[q] = *(const u32x4*)(vp + 8 * q);
#pragma unroll
        for (int g = 0; g < 4; ++g) {
            const f32x4 c0 = c0a[g], c1 = c1a[g], s0 = s0a[g], s1 = s1a[g];
            const float cs[8] = {c0.x, c0.y, c0.z, c0.w, c1.x, c1.y, c1.z, c1.w}, sn[8] = {s0.x, s0.y, s0.z, s0.w, s1.x, s1.y, s1.z, s1.w};
            float k1[8], k2[8], q1[8], q2[8];
            rk_unp8(kla[g], k1); rk_unp8(kha[g], k2); rk_unp8(qla[g], q1); rk_unp8(qha[g], q2);
            unsigned ka[8], kb[8]; float qa[8], qb[8];
#pragma unroll
            for (int t = 0; t < 8; ++t) { ka[t] = f2bf((k1[t] * cs[t] - k2[t] * sn[t]) * 0.125f); kb[t] = f2bf((k1[t] * sn[t] + k2[t] * cs[t]) * 0.125f); qa[t] = q1[t] * cs[t] - q2[t] * sn[t]; qb[t] = q1[t] * sn[t] + q2[t] * cs[t]; }
            *(u32x4*)(kp + 8 * g) = (u32x4){ka[0] | (ka[1] << 16), ka[2] | (ka[3] << 16), ka[4] | (ka[5] << 16), ka[6] | (ka[7] << 16)};
            *(u32x4*)(kp + 32 + 8 * g) = (u32x4){kb[0] | (kb[1] << 16), kb[2] | (kb[3] << 16), kb[4] | (kb[5] << 16), kb[6] | (kb[7] << 16)};
            *(u32x4*)(qp + 8 * g) = (u32x4){pk2(qa[0], qa[1]), pk2(qa[2], qa[3]), pk2(qa[4], qa[5]), pk2(qa[6], qa[7])};
            *(u32x4*)(qp + 32 + 8 * g) = (u32x4){pk2(qb[0], qb[1]), pk2(qb[2], qb[3]), pk2(qb[4], qb[5]), pk2(qb[6], qb[7])};
#pragma unroll
            for (int t = 0; t < 8; ++t) { kdt[(8 * g + t) * 68 + lane] = (bf16_t)f2bf(__uint_as_float(ka[t] << 16) * dk); kdt[(32 + 8 * g + t) * 68 + lane] = (bf16_t)f2bf(__uint_as_float(kb[t] << 16) * dk); }
        }
#pragma unroll
        for (int q = 0; q < 8; ++q) { const u32x4 w = vra[q]; LAS bf16_t* d = vtl + (8 * q) * 68 + lane;
            d[0] = (bf16_t)(w.x & 0xffffu); d[68] = (bf16_t)(w.x >> 16); d[2 * 68] = (bf16_t)(w.y & 0xffffu); d[3 * 68] = (bf16_t)(w.y >> 16);
            d[4 * 68] = (bf16_t)(w.z & 0xffffu); d[5 * 68] = (bf16_t)(w.z >> 16); d[6 * 68] = (bf16_t)(w.w & 0xffffu); d[7 * 68] = (bf16_t)(w.w >> 16); }
        asm volatile("" ::: "memory");
        bf16_t* outp = KV + ((size_t)((b * 8 + h) * 256 + c)) * 4096;
#pragma unroll
        for (int db = 0; db < 2; ++db)
#pragma unroll
            for (int eb = 0; eb < 2; ++eb) { f32x16 x;
#pragma unroll
                for (int i = 0; i < 16; ++i) x[i] = 0.f;
#pragma unroll
                for (int ks = 0; ks < 4; ++ks) { const LAS bf16_t* ap = kdt + (32 * db + r) * 68 + 16 * ks + 8 * hh; const LAS bf16_t* bp = vtl + (32 * eb + r) * 68 + 16 * ks + 8 * hh;
                    const u32x2 a0 = *(const LAS u32x2*)ap, a1 = *(const LAS u32x2*)(ap + 4), b0 = *(const LAS u32x2*)bp, b1 = *(const LAS u32x2*)(bp + 4);
                    x = MFMA32(__builtin_bit_cast(bf16x8s, (u32x4){a0.x, a0.y, a1.x, a1.y}), __builtin_bit_cast(bf16x8s, (u32x4){b0.x, b0.y, b1.x, b1.y}), x); }
#pragma unroll
                for (int gq = 0; gq < 4; ++gq) *(u32x2*)(outp + (size_t)(32 * eb + r) * 64 + 32 * db + 8 * gq + 4 * hh) = (u32x2){pk2(x[4 * gq], x[4 * gq + 1]), pk2(x[4 * gq + 2], x[4 * gq + 3])}; }
        asm volatile("" ::: "memory");
    }
}
PH_FN void ph_ret_out(ArgsR a, int L, LAS unsigned char* lds) {
    const bf16_t* PJ = (const bf16_t*)(a.ws + WS_PJ); const bf16_t* KV = (const bf16_t*)(a.ws + WS_KV); bf16_t* MX = (bf16_t*)(a.ws + WS_MX);
    const float* ng = a.in[6] + L * 512;
    const int tid = ltid(), lane = tid & 63, wave = tid >> 6, r = lane & 31, hh = lane >> 5;
    LAS bf16_t* vtl = (LAS bf16_t*)(lds + wave * 9216);
    for (int cu = blockIdx.x * 8 + wave; cu < 4096; cu += gridDim.x * 8) {
        const int b = cu >> 11, c = (cu >> 3) & 255, h = cu & 7, tok0 = b * SEQ + c * 64;
        const float lg = ret_logg(h);
        { const bf16_t* vp = PJ + (size_t)(tok0 + lane) * INW + C_RV + h * 64;
#pragma unroll
            for (int q = 0; q < 8; ++q) { const u32x4 w = *(const u32x4*)(vp + 8 * q); LAS bf16_t* d = vtl + (8 * q) * 68 + lane;
                d[0] = (bf16_t)(w.x & 0xffffu); d[68] = (bf16_t)(w.x >> 16); d[2 * 68] = (bf16_t)(w.y & 0xffffu); d[3 * 68] = (bf16_t)(w.y >> 16);
                d[4 * 68] = (bf16_t)(w.z & 0xffffu); d[5 * 68] = (bf16_t)(w.z >> 16); d[6 * 68] = (bf16_t)(w.w & 0xffffu); d[7 * 68] = (bf16_t)(w.w >> 16); } }
        asm volatile("" ::: "memory");
        const bf16_t* Rt = KV + ((size_t)((b * 8 + h) * 256 + c)) * 4096;
        const float ng0 = ng[h * 64 + r], ng1 = ng[h * 64 + 32 + r];
#pragma unroll 1
        for (int qh = 0; qh < 2; ++qh) {
            bf16x8s bq[4];
            { const bf16_t* qp = PJ + (size_t)(tok0 + 32 * qh + r) * INW + C_RQ + h * 64 + 8 * hh;
#pragma unroll
                for (int ks = 0; ks < 4; ++ks) bq[ks] = __builtin_bit_cast(bf16x8s, *(const u32x4*)(qp + 16 * ks)); }
            unsigned short gq0[16], gq1[16];
#pragma unroll
            for (int i = 0; i < 16; ++i) { const size_t tk = (size_t)tok0 + 32 * qh + (i & 3) + 8 * (i >> 2) + 4 * hh; gq0[i] = PJ[tk * INW + C_RG + h * 64 + r]; gq1[i] = PJ[tk * INW + C_RG + h * 64 + 32 + r]; }
            f32x16 o0, o1, oc0, oc1;
#pragma unroll
            for (int i = 0; i < 16; ++i) { o0[i] = 0.f; o1[i] = 0.f; oc0[i] = 0.f; oc1[i] = 0.f; }
#pragma unroll
            for (int kh = 0; kh < 2; ++kh) {
                bf16x8s ak[4];
                { const bf16_t* kp = PJ + (size_t)(tok0 + 32 * kh + r) * INW + C_RK + h * 64 + 8 * hh;
#pragma unroll
                    for (int ks = 0; ks < 4; ++ks) ak[ks] = __builtin_bit_cast(bf16x8s, *(const u32x4*)(kp + 16 * ks)); }
                f32x16 x;
#pragma unroll
                for (int i = 0; i < 16; ++i) x[i] = 0.f;
#pragma unroll
                for (int ks = 0; ks < 4; ++ks) x = MFMA32(ak[ks], bq[ks], x);
                float w[16];
#pragma unroll
                for (int i = 0; i < 16; ++i) { const int j = 32 * kh + (i & 3) + 8 * (i >> 2) + 4 * hh; w[i] = x[i] * __expf(lg * fabsf((float)(32 * qh + r - j))); }
                const bf16x8s xs0 = sb_pack8(w[0], w[1], w[2], w[3], w[4], w[5], w[6], w[7]), xs1 = sb_pack8(w[8], w[9], w[10], w[11], w[12], w[13], w[14], w[15]);
                bf16x8s pb[2][2];
#pragma unroll
                for (int s = 0; s < 2; ++s)
#pragma unroll
                    for (int dh = 0; dh < 2; ++dh) { const LAS bf16_t* vq = vtl + (32 * dh + r) * 68 + 32 * kh + 16 * s + 4 * hh; const u32x2 lo = *(const LAS u32x2*)(vq), hi = *(const LAS u32x2*)(vq + 8);
                        pb[s][dh] = __builtin_bit_cast(bf16x8s, (u32x4){lo.x, lo.y, hi.x, hi.y}); }
                o0 = MFMA32(xs0, pb[0][0], o0); o0 = MFMA32(xs1, pb[1][0], o0); o1 = MFMA32(xs0, pb[0][1], o1); o1 = MFMA32(xs1, pb[1][1], o1);
            }
#pragma unroll
            for (int ks = 0; ks < 4; ++ks) { const bf16x8s r0 = __builtin_bit_cast(bf16x8s, *(const u32x4*)(Rt + (size_t)r * 64 + 16 * ks + 8 * hh)), r1 = __builtin_bit_cast(bf16x8s, *(const u32x4*)(Rt + (size_t)(32 + r) * 64 + 16 * ks + 8 * hh));
                oc0 = MFMA32(bq[ks], r0, oc0); oc1 = MFMA32(bq[ks], r1, oc1); }
#pragma unroll
            for (int i = 0; i < 16; ++i) { const int qi = 32 * qh + (i & 3) + 8 * (i >> 2) + 4 * hh; const float f = __expf((float)(qi + 1) * lg);
                const float v0 = o0[i] + f * oc0[i], v1 = o1[i] + f * oc1[i];
                float ss = allred16(v0 * v0 + v1 * v1); ss += __shfl_xor(ss, 16);
                const float rstd = rsqrtf(ss * (1.f / 64.f) + 1e-6f);
                const size_t tok = (size_t)tok0 + qi;
                const float g0 = bf2f(gq0[i]), g1 = bf2f(gq1[i]);
                MX[tok * 1024 + h * 64 + r] = (bf16_t)f2bf(g0 * sigmoidf_(g0) * v0 * rstd * ng0); MX[tok * 1024 + h * 64 + 32 + r] = (bf16_t)f2bf(g1 * sigmoidf_(g1) * v1 * rstd * ng1); }
        }
        asm volatile("" ::: "memory");
    }
}
PH_FN void ph_rwkv_post(ArgsR a, int L) {
    const int tid = ltid(), lane = tid & 63, wave = tid >> 6, c4 = 4 * lane;
    const bf16_t* RW_R = (const bf16_t*)(a.ws + WS_NB); const bf16_t* RW_KM = RW_R + (size_t)TT * 256; const bf16_t* RW_V = RW_KM + (size_t)TT * 256;
    const bf16_t* RW_G = (const bf16_t*)(a.ws + WS_PJ + 240 * MiB); bf16_t* MX = (bf16_t*)(a.ws + WS_MX);
    const f32x4 rk = *(const f32x4*)(a.in[15] + L * 256 + c4), lw = *(const f32x4*)(a.in[16] + L * 256 + c4), lb = *(const f32x4*)(a.in[17] + L * 256 + c4);
    for (int tok = blockIdx.x * 8 + wave; tok < TT; tok += gridDim.x * 8) { const size_t idx = (size_t)tok * 256 + c4; bf16_t* yp = MX + (size_t)tok * 1024 + 768 + c4;
        const f32x4 y = bf4(*(const u32x2*)yp), r = bf4(*(const u32x2*)(RW_R + idx)), km = bf4(*(const u32x2*)(RW_KM + idx)), v = bf4(*(const u32x2*)(RW_V + idx)), g = bf4(*(const u32x2*)(RW_G + idx));
        const float mean = allred16((y.x + y.y) + (y.z + y.w)) * (1.f / 64.f); const f32x4 d = y - mean;
        const float var = allred16((d.x * d.x + d.y * d.y) + (d.z * d.z + d.w * d.w)) * (1.f / 64.f);
        const f32x4 t = r * km * rk; const float bon = allred16((t.x + t.y) + (t.z + t.w));
        const f32x4 o = (d * rsqrtf(var + 64e-5f) * lw + lb + v * bon) * g;
        *(u32x2*)yp = (u32x2){pk2(o.x, o.y), pk2(o.z, o.w)}; }
}
#define XB_TMO      128
#define XB_XCNT(j)  (256  + 64 * (j))
#define XB_XSUB(j)  (1280 + 64 * (j))
#define XB_XGEN(j)  (2304 + 64 * (j))
#define XB_TOP      3328
#define XB_TOPGEN   3392
#define XCD_BAR_WORDS 3456
#define XB_SPIN_CAP (1u << 18)

__device__ __forceinline__ unsigned xb_ld(unsigned* p)              { return __hip_atomic_load(p, __ATOMIC_RELAXED, __HIP_MEMORY_SCOPE_AGENT); }
__device__ __forceinline__ unsigned xb_add(unsigned* p, unsigned v) { return __hip_atomic_fetch_add(p, v, __ATOMIC_RELAXED, __HIP_MEMORY_SCOPE_AGENT); }
__device__ __forceinline__ unsigned xb_xcc_id() { return (unsigned)__builtin_amdgcn_s_getreg((3 << 11) | 20) & 0xFu; }
#define XB_SPIN(cond, bar) do { unsigned _sp = 0; while (cond) { __builtin_amdgcn_s_sleep(1); \
    if ((++_sp & 255u) == 0u) { if (xb_ld(&(bar)[XB_TMO])) break; if (_sp > XB_SPIN_CAP) { atomicAdd(&(bar)[XB_TMO], 1u); break; } } } } while (0)

struct XcdBarrier {
    unsigned* bar; unsigned x;
    volatile LAS unsigned* st;
};

__device__ __forceinline__ XcdBarrier xcd_barrier_post(unsigned* bar, volatile LAS unsigned* st) {
    XcdBarrier b; b.bar = bar; b.x = xb_xcc_id(); b.st = st;
    if (threadIdx.x == 0) (void)xb_add(&bar[XB_XCNT(b.x)], 1u);
    return b;
}
__device__ __forceinline__ void xcd_barrier_complete(unsigned* bar, unsigned x, unsigned& nloc, unsigned& nx) {
    const unsigned G = gridDim.x * gridDim.y * gridDim.z;
    unsigned sum, cnt, mine, sp = 0u;
    for (;;) {
        sum = 0u; cnt = 0u; mine = 0u;
#pragma unroll
        for (unsigned j = 0; j < 16; ++j) { const unsigned c = xb_ld(&bar[XB_XCNT(j)]); sum += c; cnt += (c > 0u) ? 1u : 0u; mine = (j == x) ? c : mine; }
        if (sum == G) break;
        __builtin_amdgcn_s_sleep(1);
        if ((++sp & 255u) == 0u) { if (xb_ld(&bar[XB_TMO])) break; if (sp > XB_SPIN_CAP) { atomicAdd(&bar[XB_TMO], 1u); break; } }
    }
    nloc = mine > 0u ? mine : 1u; nx = cnt > 0u ? cnt : 1u;
}

__device__ __forceinline__ void xcd_barrier(const XcdBarrier& b) {
    asm volatile("s_waitcnt vmcnt(0)" ::: "memory");
    __syncthreads();
    if (threadIdx.x == 0) {
        unsigned* bar = b.bar;
        __builtin_amdgcn_s_waitcnt(0);
        unsigned nloc = b.st[0], nx = b.st[1];
        if (nloc == 0u) { xcd_barrier_complete(bar, b.x, nloc, nx); b.st[0] = nloc; b.st[1] = nx; }
        const unsigned old = xb_add(&bar[XB_XSUB(b.x)], 1u);
        const unsigned gen = old / nloc;
        if (old + 1u == (gen + 1u) * nloc) {
            __builtin_amdgcn_fence(__ATOMIC_RELEASE, "agent");
            asm volatile("s_waitcnt vmcnt(0)" ::: "memory");
            const unsigned og = xb_add(&bar[XB_TOP], 1u);
            const unsigned tg = og / nx;
            if (og + 1u == (tg + 1u) * nx) xb_add(&bar[XB_TOPGEN], 1u);
            else XB_SPIN(xb_ld(&bar[XB_TOPGEN]) == tg, bar);
            __builtin_amdgcn_fence(__ATOMIC_ACQUIRE, "agent");
            xb_add(&bar[XB_XGEN(b.x)], 1u);
            asm volatile("s_waitcnt vmcnt(0)" ::: "memory");
        } else {
            XB_SPIN(xb_ld(&bar[XB_XGEN(b.x)]) == gen, bar);
            __builtin_amdgcn_fence(__ATOMIC_ACQUIRE, "agent");
            asm volatile("s_waitcnt vmcnt(0)" ::: "memory");
        }
    }
    __syncthreads();
}
#ifndef EN_MASK
#define EN_MASK 0xffff
#endif
#define EN(i) ((EN_MASK >> (i)) & 1)
#ifndef REP_MASK
#define REP_MASK 0
#endif
#define REP(i) (((REP_MASK >> (i)) & 1) ? 2 : 1)
#ifndef MK_PER_PHASE
#define MK_PER_PHASE 0
#endif
__global__ void __launch_bounds__(512, 2) mk_fwd(Args a_) {
    extern __shared__ __attribute__((aligned(16))) unsigned char lds_raw[];
    LAS unsigned char* lds = (LAS unsigned char*)lds_raw;
    const int G = gridDim.x, bid = blockIdx.x;
    const int ph_lo = a_.ph_lo, ph_hi = a_.ph_hi;
    volatile LAS unsigned* bst = (volatile LAS unsigned*)(lds + LDS_BYTES - 256);
    if (threadIdx.x < 2) bst[threadIdx.x] = 0u;
    __syncthreads();
    XcdBarrier xbar = xcd_barrier_post((unsigned*)(a_.ws + WS_CTL) + 1024, bst);
    for (int ph = ph_lo; ph < ph_hi; ++ph) {
        const __attribute__((address_space(4))) Args* ap = (const __attribute__((address_space(4))) Args*)__builtin_amdgcn_kernarg_segment_ptr();
        asm volatile("" : "+s"(ap));
        ArgsR a = *ap;
        bf16_t* WB = (bf16_t*)(a.ws + WS_WB); bf16_t* NB = (bf16_t*)(a.ws + WS_NB); bf16_t* PJ = (bf16_t*)(a.ws + WS_PJ); bf16_t* MX = (bf16_t*)(a.ws + WS_MX); bf16_t* PB = (bf16_t*)(a.ws + WS_KV);
        int ngemm = 0; pg8::Gemm g0{nullptr, nullptr, 0, 0, 0}, g1 = g0; pg8::EpiGen e0{0, true, nullptr, 0, nullptr, nullptr, nullptr, nullptr, nullptr, nullptr}, e1 = e0;
        unsigned long long* RSS = (unsigned long long*)(a.ws + WS_RSS);
        if (ph == 0) { if (EN(11)) ph_prologue(a); }
        else if (ph == NPHASE - 1) { if (EN(12)) ph_final(RSS + 12 * TT, a.in[23], a.out); }
        else {
            const int L = (ph - 1) / NSUB, s = (ph - 1) % NSUB;
            const int wrem = ((TT / 256) * (INW / 256)) % G;
            if (s == 0) { ph_weights(a, L, lds, wrem ? 0 : 2, bid, G); }
            else if (s == 1) { ngemm = 1; g0 = pg8::Gemm{MX, WB + WB_IN, TT, INW, DM}; e0 = pg8::EpiGen{0, true, PJ, INW, nullptr, nullptr, nullptr, nullptr, RSS + (3 * L) * TT, nullptr}; }
            else if (s == 2) { _Pragma("nounroll") for (int rp = 0; rp < REP(2); ++rp) ph_ret_kv(a, lds); __syncthreads();     _Pragma("nounroll") for (int rp = 0; rp < REP(15); ++rp) ph_rwkv_prep(a, L, lds); }
            else if (s == 3) { { _Pragma("nounroll") for (int rp = 0; rp < REP(3); ++rp) for (int u = bid; u < 8 * (SC_NC - 1); u += G) ph_scan_pass<1>(a, lds, u, L); } }
            else if (s == 4) { if (bid < 32) ph_scan_combine(a, lds, bid); else { if (bid >= G - 64) ph_ret_scan(a, bid - (G - 64)); _Pragma("nounroll") for (int rp = 0; rp < REP(13); ++rp) ph_sb(a, L, bid - 32, G - 32); } }
            else if (s == 5) { _Pragma("nounroll") for (int rp = 0; rp < REP(14); ++rp) for (int u = bid; u < 8 * SC_NC; u += G) ph_scan_pass<2>(a, lds, u, L); }
            else if (s == 6) { _Pragma("nounroll") for (int rp = 0; rp < REP(4); ++rp) ph_ret_out(a, L, lds); }
            else if (s == 7) { ph_pconv(a.in[1] + (size_t)L * TT * PLE, PB); ngemm = 1; g0 = pg8::Gemm{MX, WB + WB_O, TT, DM, DM}; e0 = pg8::EpiGen{2, true, nullptr, DM, L == 0 ? a.in[0] : a.out, a.out, NB, nullptr, nullptr, RSS + (3 * L + 1) * TT}; }
            else if (s == 8) { ngemm = 2; g0 = pg8::Gemm{NB, WB + WB_1, TT, DFF, DM}; e0 = pg8::EpiGen{1, true, PJ, DFF, nullptr, nullptr, nullptr, nullptr, RSS + (3 * L + 1) * TT, nullptr};
                g1 = pg8::Gemm{PB, WB + WB_PE, TT, DM, PLE}; e1 = pg8::EpiGen{0, true, MX, DM, nullptr, nullptr, nullptr, nullptr, nullptr, nullptr}; }
            else if (s == 9) { ngemm = 1; g0 = pg8::Gemm{PJ, WB + WB_2, TT, DM, DFF}; e0 = pg8::EpiGen{2, true, nullptr, DM, a.out, a.out, NB, nullptr, nullptr, RSS + (3 * L + 2) * TT}; }
            else { ngemm = 1; g0 = pg8::Gemm{NB, WB + WB_PG, TT, DM, DM}; e0 = pg8::EpiGen{3, true, nullptr, DM, a.out, a.out, MX, MX, RSS + (3 * L + 2) * TT, RSS + (3 * L + 3) * TT}; }
        }
        const int grep_ = 1;
        for (int gi = 0; gi < ngemm * grep_; ++gi) {
            const pg8::Gemm g = (gi % ngemm) ? g1 : g0; const pg8::EpiGen E = (gi % ngemm) ? e1 : e0;
            pg8::StaticOrder S; S.init(g.M, g.N, G, bid);
            pg8::gemm_phase<pg8::EpiGen, pg8::StaticOrder, true, true>(lds, g, S, E);
            __syncthreads();
        }
        if (ph > 0 && ph < NPHASE - 1 && ((ph - 1) % NSUB) == 1) { const int wrem2 = ((TT / 256) * (INW / 256)) % G; if (wrem2 && bid >= wrem2) ph_weights(a, (ph - 1) / NSUB, lds, 1, bid - wrem2, G - wrem2); }
        if (ph + 1 < ph_hi) { if (ph == ph_lo) cg::this_grid().sync(); else xcd_barrier(xbar); }
    }
}

extern "C" void kernel_launch(void* const* d_in, const int* in_sizes, int n_in, void* d_out, int out_size, void* d_ws, size_t ws_size, hipStream_t stream) {
    static int grid = 0;
    if (grid == 0) {
        if (n_in != 24 || out_size != TT * DM || ws_size < WS_END) { fprintf(stderr, "kernel_launch: unexpected shapes (n_in %d, out %d, ws %zu); nothing launched\n", n_in, out_size, ws_size); grid = -1; return; }
        int dev = 0, cus = 0, per_cu = 0;
        (void)hipGetDevice(&dev); (void)hipDeviceGetAttribute(&cus, hipDeviceAttributeMultiprocessorCount, dev);
        if (hipFuncSetAttribute((const void*)mk_fwd, hipFuncAttributeMaxDynamicSharedMemorySize, LDS_BYTES) != hipSuccess) fprintf(stderr, "kernel_launch: hipFuncSetAttribute failed\n");
        if (hipOccupancyMaxActiveBlocksPerMultiprocessor(&per_cu, (const void*)mk_fwd, 512, LDS_BYTES) != hipSuccess || per_cu < 1) { fprintf(stderr, "kernel_launch: occupancy query says %d\n", per_cu); per_cu = 1; }
        (void)hipGetLastError();
        grid = cus * 1;
        if (grid <= 16) grid = 256;
    }
    if (grid < 0) return;
    (void)hipMemsetAsync((char*)d_ws + WS_CTL, 0, 65536, stream);
    Args a{};
    for (int i = 0; i < 24; ++i) a.in[i] = (const float*)d_in[i];
    a.out = (float*)d_out; a.ws = (unsigned char*)d_ws;
#if MK_PER_PHASE
    for (int ph = 0; ph < NPHASE; ++ph) { a.ph_lo = ph; a.ph_hi = ph + 1; hipLaunchKernelGGL(mk_fwd, dim3(grid), dim3(512), LDS_BYTES, stream, a); }
#else
    a.ph_lo = 0; a.ph_hi = NPHASE;
    void* args[] = {&a};
    hipError_t e = hipLaunchCooperativeKernel((void*)mk_fwd, dim3(grid), dim3(512), args, LDS_BYTES, stream);
    if (e != hipSuccess) fprintf(stderr, "cooperative launch failed: %s (grid %d)\n", hipGetErrorString(e), grid);
#endif
}
```

```cpp
#include <hip/hip_runtime.h>
#include <hip/hip_cooperative_groups.h>
#include <cstdio>
#include <cstdint>
namespace cg = cooperative_groups;
namespace pg8 {
#define PG8_LAS __attribute__((address_space(3)))
typedef unsigned short bf16_t;
typedef short bf16x8 __attribute__((ext_vector_type(8)));
typedef float f32x4 __attribute__((ext_vector_type(4)));
typedef unsigned u32x4 __attribute__((ext_vector_type(4)));
constexpr int BM = 256, BK = 64, HALF = 128, HTB = HALF * BK * 2  , STAGE_BYTES = 8 * HTB, NXCD = 8, WGM = 8;

__host__ __device__ __forceinline__ int lds_byte(int r, int c) { const int st = (r >> 4) * 2 + (c >> 5), rr = r & 15, cc = c & 31, ob = rr * 64 + cc * 2; return st * 1024 + (ob ^ (((ob >> 9) & 1) << 5)); }
__host__ __device__ __forceinline__ void stage_rc(int b, int& R, int& C) { const int st = b / 1024, sb = b % 1024, swz = sb ^ (((sb >> 9) & 1) << 5); R = (st >> 1) * 16 + swz / 64; C = (st & 1) * 32 + (swz % 64) / 2; }
__host__ __device__ __forceinline__ int perm32(int rho) { const int n = rho >> 4, i = rho & 15; return 8 * (i >> 2) + 4 * n + (i & 3); }

struct Unit { int pm, pn; };
struct Gemm { const bf16_t* A; const bf16_t* Bt; int M, N, K; };

struct StaticOrder {
    int nM, nN, nwg, G, c;
    __host__ __device__ void init(int M, int N, int G_, int c_) { nM = M / BM; nN = N / BM; nwg = nM * nN; G = G_; c = c_; }
    __host__ __device__ bool next(int i, Unit& u) const {
        const long L = (long)i * G + c; if (L >= nwg) return false;
        int wgid = (int)L; { const int q = nwg / NXCD, r = nwg % NXCD, xcd = wgid % NXCD, off = wgid / NXCD; wgid = (xcd < r ? xcd * (q + 1) : r * (q + 1) + (xcd - r) * q) + off; }
        const int nig = WGM * nN, gid = wgid / nig, fm = gid * WGM, gsz = (nM - fm) < WGM ? (nM - fm) : WGM;
        u.pm = fm + ((wgid % nig) % gsz); u.pn = (wgid % nig) / gsz; return true;
    }
    __device__ __forceinline__ void a_ready(const Unit&) const {}
    __device__ __forceinline__ void done(const Unit&) const {}
};

__device__ __forceinline__ unsigned cvt_pk_bf16(float lo, float hi) { unsigned r; asm volatile("v_cvt_pk_bf16_f32 %0, %1, %2" : "=v"(r) : "v"(lo), "v"(hi)); return r; }
template <int ACT> struct EpiBf16 {
    static constexpr bool PERM = true, AFTER_DRAIN = false;
    bf16_t* O; int ldc;
    __device__ __forceinline__ void operator()(const f32x4 (&acc)[2][2][4][2], const Unit& u, int wr, int wc, int fr, int fq) const {
        const int row0 = u.pm * BM + wr * 64 + fr; const int col0 = u.pn * BM + wc * 32 + 8 * fq;
#pragma unroll
        for (int ai = 0; ai < 2; ++ai)
#pragma unroll
            for (int m = 0; m < 4; ++m) { bf16_t* rowp = O + (size_t)(row0 + ai * HALF + m * 16) * ldc + col0;
#pragma unroll
                for (int bj = 0; bj < 2; ++bj) { f32x4 v0 = acc[ai][bj][m][0], v1 = acc[ai][bj][m][1];
                    if (ACT == 1) {
#pragma unroll
                        for (int q = 0; q < 4; ++q) { float a = fmaxf(v0[q], 0.f), b = fmaxf(v1[q], 0.f); v0[q] = a * a; v1[q] = b * b; } }
                    u32x4 w; w.x = cvt_pk_bf16(v0[0], v0[1]); w.y = cvt_pk_bf16(v0[2], v0[3]); w.z = cvt_pk_bf16(v1[0], v1[1]); w.w = cvt_pk_bf16(v1[2], v1[3]);
                    *(u32x4*)(rowp + bj * HALF) = w; } }
    }
};
template <int GATE> struct EpiRes {
    static constexpr bool PERM = false, AFTER_DRAIN = false;
    const float* base; float* out; const bf16_t* pe; int ldc;
    __device__ __forceinline__ void operator()(const f32x4 (&acc)[2][2][4][2], const Unit& u, int wr, int wc, int fr, int fq) const {
        const int col0 = u.pn * BM + wc * 32 + 4 * fq;
#pragma unroll
        for (int ai = 0; ai < 2; ++ai)
#pragma unroll
            for (int m = 0; m < 4; ++m) { const size_t off = (size_t)(u.pm * BM + ai * HALF + wr * 64 + m * 16 + fr) * ldc + col0;
#pragma unroll
                for (int bj = 0; bj < 2; ++bj)
#pragma unroll
                    for (int n = 0; n < 2; ++n) { const size_t o2 = off + bj * HALF + n * 16; const f32x4 bs = *(const f32x4*)(base + o2); f32x4 a = acc[ai][bj][m][n];
                        if (GATE) { const uint2 pw = *(const uint2*)(pe + o2); float p0 = __uint_as_float(pw.x << 16), p1 = __uint_as_float(pw.x & 0xffff0000u), p2 = __uint_as_float(pw.y << 16), p3 = __uint_as_float(pw.y & 0xffff0000u);
                            a[0] = p0 / (1.f + __expf(-a[0])); a[1] = p1 / (1.f + __expf(-a[1])); a[2] = p2 / (1.f + __expf(-a[2])); a[3] = p3 / (1.f + __expf(-a[3])); }
                        *(f32x4*)(out + o2) = bs + a; } }
    }
};

struct EpiGen {
    static constexpr bool AFTER_DRAIN = false;
    int mode; bool perm; bf16_t* O; int ldc; const float* hbase; float* hout; bf16_t* hcopy; const bf16_t* pe; const unsigned long long* rss_in; unsigned long long* rss_out;
    __device__ __forceinline__ void operator()(const f32x4 (&acc)[2][2][4][2], const Unit& u, int wr, int wc, int fr, int fq) const {
        if (mode < 2) {
            const int row0 = u.pm * BM + wr * 64 + fr; const int col0 = u.pn * BM + wc * 32 + 8 * fq; const bool sq = (mode == 1);
#pragma unroll
            for (int ai = 0; ai < 2; ++ai)
#pragma unroll
                for (int m = 0; m < 4; ++m) { const int row = row0 + ai * HALF + m * 16; bf16_t* rowp = O + (size_t)row * ldc + col0;
                    const float rs = rss_in ? rsqrtf((float)rss_in[row] * (1.f / (1024.f * 1048576.f)) + 1e-6f) : 1.f;
#pragma unroll
                    for (int bj = 0; bj < 2; ++bj) { f32x4 v0 = acc[ai][bj][m][0] * rs, v1 = acc[ai][bj][m][1] * rs;
                        if (sq) {
#pragma unroll
                            for (int q = 0; q < 4; ++q) { float a = fmaxf(v0[q], 0.f), b = fmaxf(v1[q], 0.f); v0[q] = a * a; v1[q] = b * b; } }
                        u32x4 w; w.x = cvt_pk_bf16(v0[0], v0[1]); w.y = cvt_pk_bf16(v0[2], v0[3]); w.z = cvt_pk_bf16(v1[0], v1[1]); w.w = cvt_pk_bf16(v1[2], v1[3]);
                        *(u32x4*)(rowp + bj * HALF) = w; } }
        } else {
            const int col0 = u.pn * BM + wc * 32 + 8 * fq; const bool gate = (mode == 3);
#pragma unroll
            for (int ai = 0; ai < 2; ++ai) {
#pragma unroll
              for (int mp = 0; mp < 2; ++mp) {
                f32x4 pre[4][2][2]; u32x4 pq_[2][2];
#pragma unroll
                for (int m = 2 * mp; m < 2 * mp + 2; ++m) { const size_t off = (size_t)(u.pm * BM + ai * HALF + wr * 64 + m * 16 + fr) * ldc + col0;
#pragma unroll
                    for (int bj = 0; bj < 2; ++bj)
#pragma unroll
                        for (int n = 0; n < 2; ++n) pre[m][bj][n] = *(const f32x4*)(hbase + off + bj * HALF + n * 4);
                    if (gate) {
#pragma unroll
                        for (int bj = 0; bj < 2; ++bj) pq_[m & 1][bj] = *(const u32x4*)(pe + off + bj * HALF); } }
#pragma unroll
                for (int m = 2 * mp; m < 2 * mp + 2; ++m) { const int row = u.pm * BM + ai * HALF + wr * 64 + m * 16 + fr; const size_t off = (size_t)row * ldc + col0;
                    const float rs = gate ? rsqrtf((float)rss_in[row] * (1.f / (1024.f * 1048576.f)) + 1e-6f) : 1.f; float ssum = 0.f;
#pragma unroll
                    for (int bj = 0; bj < 2; ++bj) { const size_t o2 = off + bj * HALF; f32x4 a0 = acc[ai][bj][m][0], a1 = acc[ai][bj][m][1];
                        if (gate) { const u32x4 pq = pq_[m & 1][bj];
                            a0[0] = __uint_as_float(pq.x << 16) / (1.f + __expf(-a0[0] * rs)); a0[1] = __uint_as_float(pq.x & 0xffff0000u) / (1.f + __expf(-a0[1] * rs)); a0[2] = __uint_as_float(pq.y << 16) / (1.f + __expf(-a0[2] * rs)); a0[3] = __uint_as_float(pq.y & 0xffff0000u) / (1.f + __expf(-a0[3] * rs));
                            a1[0] = __uint_as_float(pq.z << 16) / (1.f + __expf(-a1[0] * rs)); a1[1] = __uint_as_float(pq.z & 0xffff0000u) / (1.f + __expf(-a1[1] * rs)); a1[2] = __uint_as_float(pq.w << 16) / (1.f + __expf(-a1[2] * rs)); a1[3] = __uint_as_float(pq.w & 0xffff0000u) / (1.f + __expf(-a1[3] * rs)); }
                        const f32x4 h0 = pre[m][bj][0] + a0, h1 = pre[m][bj][1] + a1;
                        ssum += ((h0[0] * h0[0] + h0[1] * h0[1]) + (h0[2] * h0[2] + h0[3] * h0[3])) + ((h1[0] * h1[0] + h1[1] * h1[1]) + (h1[2] * h1[2] + h1[3] * h1[3]));
                        *(f32x4*)(hout + o2) = h0; *(f32x4*)(hout + o2 + 4) = h1;
                        u32x4 ow; ow.x = cvt_pk_bf16(h0[0], h0[1]); ow.y = cvt_pk_bf16(h0[2], h0[3]); ow.z = cvt_pk_bf16(h1[0], h1[1]); ow.w = cvt_pk_bf16(h1[2], h1[3]); *(u32x4*)(hcopy + o2) = ow; }
                    ssum += __shfl_xor(ssum, 16); ssum += __shfl_xor(ssum, 32);
                    if (fq == 0) atomicAdd(rss_out + row, (unsigned long long)__float2ll_rn(ssum * 1048576.f)); }
              }
            }
        }
    }
};

template <class Epi, class Sched, bool ALIGN_EPI = false, bool SP2 = false>
__device__ __forceinline__ void gemm_phase(PG8_LAS unsigned char* lds, const Gemm g, const Sched& S, const Epi& E) {
    const int tid = threadIdx.x, wid = __builtin_amdgcn_readfirstlane(tid >> 6), lane = tid & 63, wr = wid >> 2, wc = wid & 3, fr = lane & 15, fq = lane >> 4;
    const int K = g.K, nt = K / BK;
    unsigned voffA[2], voffB[2];
#pragma unroll
    for (int i = 0; i < 2; ++i) { int R, C; stage_rc(tid * 16 + i * 8192, R, C); const int Rb = E.perm ? ((R & ~31) + perm32(R & 31)) : R;
        voffA[i] = (unsigned)(R * K + C) * 2u; voffB[i] = (unsigned)(Rb * K + C) * 2u; }
    const size_t kstep = (size_t)(BK * 2);
    const size_t hstep = (size_t)HALF * K * 2;
    const size_t tstep = 2 * hstep;
    const unsigned ldsw = (unsigned)wid * 1024u;
    const int aoff = lds_byte(wr * 64 + fr, fq * 8), boff = lds_byte(wc * 32 + fr, fq * 8);
#define PG8_SA(b, h) (((b) * 2 + (h)) * HTB)
#define PG8_SB(b, h) ((4 + (b) * 2 + (h)) * HTB)
#define PG8_STAGE(bufoff, gbase, voff) do { _Pragma("unroll") for (int _i = 0; _i < 2; ++_i) \
        __builtin_amdgcn_global_load_lds((const unsigned*)((const char*)(gbase) + (voff)[_i]), (PG8_LAS unsigned*)(lds + (bufoff) + ldsw + _i * 8192), 16, 0, 0); } while (0)
#define PG8_LDA(dst, b, h) do { _Pragma("unroll") for (int m = 0; m < 4; ++m) _Pragma("unroll") for (int k = 0; k < 2; ++k) dst[m][k] = *(const PG8_LAS bf16x8*)(lds + PG8_SA(b, h) + aoff + m * 2048 + k * 1024); } while (0)
#define PG8_LDB(dst, b, h) do { _Pragma("unroll") for (int n = 0; n < 2; ++n) _Pragma("unroll") for (int k = 0; k < 2; ++k) dst[n][k] = *(const PG8_LAS bf16x8*)(lds + PG8_SB(b, h) + boff + n * 2048 + k * 1024); } while (0)
#define PG8_MMA(ai, bj, At, Bt) do { __builtin_amdgcn_s_setprio(1); _Pragma("unroll") for (int m = 0; m < 4; ++m) _Pragma("unroll") for (int n = 0; n < 2; ++n) _Pragma("unroll") for (int k = 0; k < 2; ++k) \
        acc[ai][bj][m][n] = __builtin_amdgcn_mfma_f32_16x16x32_bf16(Bt[n][k], At[m][k], acc[ai][bj][m][n], 0, 0, 0); __builtin_amdgcn_s_setprio(0); } while (0)
#define PG8_WAIT_V(n) asm volatile("s_waitcnt vmcnt(" #n ")" ::: "memory")
#define PG8_WAIT_L(n) asm volatile("s_waitcnt lgkmcnt(" #n ")" ::: "memory")
#define PG8_BAR __builtin_amdgcn_s_barrier()
#define PG8_SCHED __builtin_amdgcn_sched_barrier(0)
    Unit cur, nxt; int ui = 0;
    if (!S.next(0, cur)) return;
    f32x4 acc[2][2][4][2];
#pragma unroll
    for (int a = 0; a < 2; ++a)
#pragma unroll
        for (int b = 0; b < 2; ++b)
#pragma unroll
            for (int m = 0; m < 4; ++m)
#pragma unroll
                for (int n = 0; n < 2; ++n) acc[a][b][m][n] = (f32x4){0.f, 0.f, 0.f, 0.f};
    bf16x8 At[4][2], B0[2][2], B1[2][2];
    const char* cA = (const char*)g.A + (size_t)cur.pm * tstep; const char* cB = (const char*)g.Bt + (size_t)cur.pn * tstep;
    S.a_ready(cur);
    if constexpr (SP2) {
        PG8_STAGE(PG8_SB(0, 0), cB, voffB); PG8_STAGE(PG8_SB(0, 1), cB + hstep, voffB); PG8_STAGE(PG8_SA(0, 0), cA, voffA); PG8_STAGE(PG8_SA(0, 1), cA + hstep, voffA);
        if (wr == 1) PG8_BAR;
        PG8_WAIT_V(2); PG8_BAR;
        PG8_STAGE(PG8_SB(1, 0), cB + kstep, voffB); PG8_STAGE(PG8_SA(1, 0), cA + kstep, voffA); PG8_STAGE(PG8_SB(1, 1), cB + hstep + kstep, voffB);
        PG8_WAIT_V(6); PG8_BAR;
    } else {
        PG8_STAGE(PG8_SB(0, 0), cB, voffB); PG8_STAGE(PG8_SA(0, 0), cA, voffA); PG8_STAGE(PG8_SB(0, 1), cB + hstep, voffB); PG8_STAGE(PG8_SA(0, 1), cA + hstep, voffA);
        if (wr == 1) PG8_BAR;
        PG8_WAIT_V(4); PG8_BAR;
        PG8_STAGE(PG8_SB(1, 0), cB + kstep, voffB); PG8_STAGE(PG8_SA(1, 0), cA + kstep, voffA); PG8_STAGE(PG8_SB(1, 1), cB + hstep + kstep, voffB);
        PG8_WAIT_V(6); PG8_BAR;
    }
    for (;;) {
        const bool has_next = S.next(ui + 1, nxt);
        const char* nA = has_next ? (const char*)g.A + (size_t)nxt.pm * tstep : cA; const char* nB = has_next ? (const char*)g.Bt + (size_t)nxt.pn * tstep : cB;
        for (int t = 0; t < nt; t += 2) {
            const bool last = (t == nt - 2);
            const char* a1 = cA + (size_t)(t + 1) * kstep;
            const char* a2 = last ? nA : cA + (size_t)(t + 2) * kstep; const char* b2 = last ? nB : cB + (size_t)(t + 2) * kstep;
            const char* a3 = a2 + kstep; const char* b3 = b2 + kstep;
            if (last && has_next) S.a_ready(nxt);
            if constexpr (SP2) {
            PG8_LDB(B0, 0, 0); PG8_LDB(B1, 0, 1); PG8_SCHED; PG8_LDA(At, 0, 0); PG8_STAGE(PG8_SA(1, 1), a1 + hstep, voffA);
            PG8_WAIT_V(8); PG8_WAIT_L(0); PG8_BAR; PG8_MMA(0, 0, At, B0); PG8_MMA(0, 1, At, B1); PG8_BAR; PG8_SCHED;
            PG8_LDA(At, 0, 1); PG8_STAGE(PG8_SB(0, 0), b2, voffB); PG8_STAGE(PG8_SB(0, 1), b2 + hstep, voffB); PG8_STAGE(PG8_SA(0, 0), a2, voffA);
            PG8_WAIT_V(8); PG8_WAIT_L(0); PG8_BAR; PG8_MMA(1, 0, At, B0); PG8_MMA(1, 1, At, B1); PG8_BAR; PG8_SCHED;
            PG8_LDB(B0, 1, 0); PG8_LDB(B1, 1, 1); PG8_SCHED; PG8_LDA(At, 1, 0); PG8_STAGE(PG8_SA(0, 1), a2 + hstep, voffA);
            PG8_WAIT_V(8); PG8_WAIT_L(0); PG8_BAR; PG8_MMA(0, 0, At, B0); PG8_MMA(0, 1, At, B1); PG8_BAR; PG8_SCHED;
            PG8_LDA(At, 1, 1); PG8_STAGE(PG8_SB(1, 0), b3, voffB); PG8_STAGE(PG8_SB(1, 1), b3 + hstep, voffB); PG8_STAGE(PG8_SA(1, 0), a3, voffA);
            PG8_WAIT_V(8); PG8_WAIT_L(0); PG8_BAR; PG8_MMA(1, 0, At, B0); PG8_MMA(1, 1, At, B1); PG8_BAR; PG8_SCHED;
            } else {
            PG8_LDB(B0, 0, 0); PG8_SCHED; PG8_LDA(At, 0, 0); PG8_STAGE(PG8_SA(1, 1), a1 + hstep, voffA);
            PG8_WAIT_L(8); PG8_BAR; PG8_WAIT_L(0); PG8_MMA(0, 0, At, B0); PG8_BAR; PG8_SCHED;
            PG8_LDB(B1, 0, 1); PG8_STAGE(PG8_SB(0, 0), b2, voffB);
            PG8_BAR; PG8_WAIT_L(0); PG8_MMA(0, 1, At, B1); PG8_BAR;
            PG8_LDA(At, 0, 1); PG8_STAGE(PG8_SA(0, 0), a2, voffA);
            PG8_BAR; PG8_WAIT_L(0); PG8_MMA(1, 0, At, B0); PG8_BAR; PG8_SCHED;
            PG8_STAGE(PG8_SB(0, 1), b2 + hstep, voffB);
            PG8_WAIT_V(6); PG8_BAR; PG8_MMA(1, 1, At, B1); PG8_BAR;
            PG8_LDB(B0, 1, 0); PG8_SCHED; PG8_LDA(At, 1, 0); PG8_STAGE(PG8_SA(0, 1), a2 + hstep, voffA);
            PG8_WAIT_L(8); PG8_BAR; PG8_WAIT_L(0); PG8_MMA(0, 0, At, B0); PG8_BAR; PG8_SCHED;
            PG8_LDB(B1, 1, 1); PG8_STAGE(PG8_SB(1, 0), b3, voffB);
            PG8_BAR; PG8_WAIT_L(0); PG8_MMA(0, 1, At, B1); PG8_BAR;
            PG8_LDA(At, 1, 1); PG8_STAGE(PG8_SA(1, 0), a3, voffA);
            PG8_BAR; PG8_WAIT_L(0); PG8_MMA(1, 0, At, B0); PG8_BAR; PG8_SCHED;
            PG8_STAGE(PG8_SB(1, 1), b3 + hstep, voffB);
            PG8_WAIT_V(6); PG8_BAR; PG8_MMA(1, 1, At, B1); PG8_BAR;
            }
        }
        if constexpr (ALIGN_EPI) { if (wr == 0) PG8_BAR; }
        if constexpr (!Epi::AFTER_DRAIN) { E(acc, cur, wr, wc, fr, fq); S.done(cur); }
        if (!has_next) break;
#pragma unroll
        for (int a = 0; a < 2; ++a)
#pragma unroll
            for (int b = 0; b < 2; ++b)
#pragma unroll
                for (int m = 0; m < 4; ++m)
#pragma unroll
                    for (int n = 0; n < 2; ++n) acc[a][b][m][n] = (f32x4){0.f, 0.f, 0.f, 0.f};
        cur = nxt; cA = nA; cB = nB; ++ui;
        if constexpr (ALIGN_EPI) { if (wr == 1) PG8_BAR; }
    }
    PG8_WAIT_V(0);
    if constexpr (!ALIGN_EPI) { if (wr == 0) PG8_BAR; }
    PG8_BAR;
    if constexpr (Epi::AFTER_DRAIN) { E.fused(acc, cur, wr, wc, fr, fq, lds, wid, lane); S.done(cur); }
#undef PG8_SA
#undef PG8_SB
#undef PG8_STAGE
#undef PG8_LDA
#undef PG8_LDB
#undef PG8_MMA
#undef PG8_WAIT_V
#undef PG8_WAIT_L
#undef PG8_BAR
#undef PG8_SCHED
}
}
#define LAS __attribute__((address_space(3)))
typedef unsigned short bf16_t;
typedef float f32x4 __attribute__((ext_vector_type(4)));
typedef unsigned u32x4 __attribute__((ext_vector_type(4)));
typedef unsigned u32x2 __attribute__((ext_vector_type(2)));
typedef short bf16x8s __attribute__((ext_vector_type(8)));
typedef float f32x16 __attribute__((ext_vector_type(16)));
#define MFMA32(a_, b_, c_) __builtin_amdgcn_mfma_f32_32x32x16_bf16((a_), (b_), (c_), 0, 0, 0)
constexpr int SEQ = 16384, TT = 32768, DM = 1024, INW = 3840, DFF = 4096, PLE = 256, DEPTH = 4;
constexpr int C_RQ = 0, C_RK = 512, C_RV = 1024, C_RG = 1536, C_SQ = 2048, C_SK = 2304, C_SV = 2560, C_Z = 2816;
constexpr size_t MiB = 1048576;
constexpr size_t WS_CTL = 0, WS_LORA = 65536, WS_ROPE = 1 * MiB, WS_WB = 5 * MiB, WS_NB = 33 * MiB, WS_PJ = 97 * MiB, WS_MX = 353 * MiB, WS_KV = 417 * MiB, WS_RWX = 449 * MiB, WS_VT = 481 * MiB, WS_HP = 497 * MiB, WS_SC = WS_WB  , WS_RSS = 507 * MiB, WS_END = 511 * MiB;
constexpr size_t WB_IN = 0, WB_O = WB_IN + (size_t)INW * DM, WB_1 = WB_O + (size_t)DM * DM, WB_2 = WB_1 + (size_t)DFF * DM, WB_PG = WB_2 + (size_t)DM * DFF, WB_PE = WB_PG + (size_t)DM * DM;
constexpr int LDS_BYTES = 147456;
constexpr int NPHASE = 46, NSUB = 11;

struct Args { const float* in[24]; float* out; unsigned char* ws; int ph_lo, ph_hi; };
typedef const __attribute__((address_space(4))) Args& ArgsR;
#define PH_FN __device__ __forceinline__

__device__ __forceinline__ int ltid() { int t = threadIdx.x; asm volatile("" : "+v"(t)); return t; }
__device__ __forceinline__ float bf2f(bf16_t v) { return __uint_as_float((unsigned)v << 16); }
__device__ __forceinline__ float bflo(unsigned w) { return __uint_as_float(w << 16); }
__device__ __forceinline__ float bfhi(unsigned w) { return __uint_as_float(w & 0xffff0000u); }
typedef __bf16 hbf16x2 __attribute__((ext_vector_type(2)));
typedef float hf32x2 __attribute__((ext_vector_type(2)));
__device__ __forceinline__ unsigned pk2(float lo, float hi) { const hf32x2 f = {lo, hi}; return __builtin_bit_cast(unsigned, __builtin_convertvector(f, hbf16x2)); }
__device__ __forceinline__ unsigned f2bf(float f) { return pk2(f, 0.f) & 0xffffu; }
__device__ __forceinline__ float wave_sum(float v) {
#pragma unroll
    for (int o = 1; o < 64; o <<= 1) v += __shfl_xor(v, o);
    return v;
}
template <int CTRL> __device__ __forceinline__ float dpp_mov(float x) { return __int_as_float(__builtin_amdgcn_update_dpp(0, __float_as_int(x), CTRL, 0xf, 0xf, false)); }
__device__ __forceinline__ float allred16(float x) { x += dpp_mov<0x128>(x); x += dpp_mov<0x124>(x); x += dpp_mov<0x122>(x); x += dpp_mov<0x121>(x); return x; }
__device__ __forceinline__ float allred4(float x) { x += dpp_mov<0xB1>(x); x += dpp_mov<0x4E>(x); return x; }
__device__ __forceinline__ float sigmoidf_(float x) { return 1.f / (1.f + __expf(-x)); }
__device__ __forceinline__ float softplusf_(float x) { return fmaxf(x, 0.f) + __logf(1.f + __expf(-fabsf(x))); }
__device__ __forceinline__ float ret_logg(int h) { return logf(1.f - exp2f(-5.f - (float)h)); }

PH_FN void ph_prologue(ArgsR a) {
    { unsigned long long* rss = (unsigned long long*)(a.ws + WS_RSS);
        for (int i = blockIdx.x * 512 + ltid(); i < 12 * TT; i += gridDim.x * 512) rss[TT + i] = 0ull;
        const int lane = ltid() & 63, wave = ltid() >> 6; bf16_t* H = (bf16_t*)(a.ws + WS_MX);
        for (int m = blockIdx.x * 8 + wave; m < TT; m += gridDim.x * 16) { const int m2 = m + gridDim.x * 8;
            const f32x4* xr = (const f32x4*)(a.in[0] + (size_t)m * DM) + lane; const f32x4* xr2 = (const f32x4*)(a.in[0] + (size_t)(m2 < TT ? m2 : m) * DM) + lane; f32x4 va[4], vb[4];
#pragma unroll
            for (int j = 0; j < 4; ++j) { va[j] = xr[64 * j]; vb[j] = xr2[64 * j]; }
            float s = 0.f, s2 = 0.f;
#pragma unroll
            for (int j = 0; j < 4; ++j) { const f32x4 v = va[j]; s += (v.x * v.x + v.y * v.y) + (v.z * v.z + v.w * v.w); u32x2 w; w.x = pk2(v.x, v.y); w.y = pk2(v.z, v.w); ((u32x2*)(H + (size_t)m * DM))[lane + 64 * j] = w; }
            if (m2 < TT) {
#pragma unroll
                for (int j = 0; j < 4; ++j) { const f32x4 v = vb[j]; s2 += (v.x * v.x + v.y * v.y) + (v.z * v.z + v.w * v.w); u32x2 w; w.x = pk2(v.x, v.y); w.y = pk2(v.z, v.w); ((u32x2*)(H + (size_t)m2 * DM))[lane + 64 * j] = w; }
                s2 = wave_sum(s2); if (lane == 0) rss[m2] = (unsigned long long)__float2ll_rn(s2 * 1048576.f); }
            s = wave_sum(s); if (lane == 0) rss[m] = (unsigned long long)__float2ll_rn(s * 1048576.f); } }
    float* cosT = (float*)(a.ws + WS_ROPE); float* sinT = cosT + SEQ * 32;
    for (int idx = blockIdx.x * 512 + ltid(); idx < SEQ * 32; idx += gridDim.x * 512) {
        const int pos = idx >> 5, i = idx & 31;
        double inv = 1.0, f = 0.7429639507594948;
#pragma unroll
        for (int bit = 0; bit < 5; ++bit) { if ((i >> bit) & 1) inv *= f; f *= f; }
        const double ang = (double)pos * inv;
        const double n = rint(ang * 0.15915494309189535);
        const float r = (float)(ang - n * 6.283185307179586);
        cosT[idx] = __cosf(r); sinT[idx] = __sinf(r);
    }
}
__device__ __forceinline__ void transpose_item(const float* W, int K, int N, bf16_t* WT, LAS float* scr, int item, int lane, const float* g = nullptr) {
    const int nblk = N / 32, kb = item / nblk, nb = item % nblk, k0 = 64 * kb, n0 = 32 * nb;
    float tv[32];
#pragma unroll
    for (int i = 0; i < 32; ++i) { const int kk = 2 * i + (lane >> 5); tv[i] = W[(size_t)(k0 + kk) * N + n0 + (lane & 31)]; }
#pragma unroll
    for (int i = 0; i < 32; ++i) { const int kk = 2 * i + (lane >> 5); scr[kk * 33 + (lane & 31)] = tv[i] * (g ? g[k0 + kk] : 1.f); }
    asm volatile("s_waitcnt lgkmcnt(0)" ::: "memory");
    const int c = lane & 7;
#pragma unroll
    for (int j = 0; j < 4; ++j) { const int n = (lane >> 3) + 8 * j; const LAS float* s = scr + (8 * c) * 33 + n;
        u32x4 o; o.x = pk2(s[0 * 33], s[1 * 33]); o.y = pk2(s[2 * 33], s[3 * 33]); o.z = pk2(s[4 * 33], s[5 * 33]); o.w = pk2(s[6 * 33], s[7 * 33]);
        *(u32x4*)(WT + (size_t)(n0 + n) * K + k0 + 8 * c) = o; }
    asm volatile("s_waitcnt lgkmcnt(0)" ::: "memory");
}
PH_FN void ph_weights(ArgsR a, int L, LAS unsigned char* lds, int part, int first, int nblk) {
    const int lane = ltid() & 63, wave = ltid() >> 6;
    LAS float* scr = (LAS float*)(lds + wave * 16384);
    bf16_t* WB = (bf16_t*)(a.ws + WS_WB);
    const int gw = first * 8 + wave, NGW = nblk * 8;
    constexpr int I_IN = (DM / 64) * (INW / 32), I_O = (DM / 64) * (DM / 32), I_1 = (DM / 64) * (DFF / 32), I_2 = (DFF / 64) * (DM / 32), I_PG = I_O, I_PE = (PLE / 64) * (DM / 32);
    constexpr int NITEMS = I_IN + I_O + I_1 + I_2 + I_PG + I_PE;
    for (int it = gw + (part == 1 ? I_IN : 0); it < (part == 0 ? I_IN : NITEMS); it += NGW) {
        int r = it;
        if (r < I_IN) { transpose_item(a.in[5] + (size_t)L * DM * INW, DM, INW, WB + WB_IN, scr, r, lane, a.in[2] + L * DM); continue; } r -= I_IN;
        if (r < I_O) { transpose_item(a.in[18] + (size_t)L * DM * DM, DM, DM, WB + WB_O, scr, r, lane); continue; } r -= I_O;
        if (r < I_1) { transpose_item(a.in[19] + (size_t)L * DM * DFF, DM, DFF, WB + WB_1, scr, r, lane, a.in[3] + L * DM); continue; } r -= I_1;
        if (r < I_2) { transpose_item(a.in[20] + (size_t)L * DFF * DM, DFF, DM, WB + WB_2, scr, r, lane); continue; } r -= I_2;
        if (r < I_PG) { transpose_item(a.in[22] + (size_t)L * DM * DM, DM, DM, WB + WB_PG, scr, r, lane, a.in[4] + L * DM); continue; } r -= I_PG;
        transpose_item(a.in[21] + (size_t)L * PLE * DM, PLE, DM, WB + WB_PE, scr, r, lane);
    }
    { bf16_t* LW = (bf16_t*)(a.ws + WS_LORA);
        for (int it = gw; it < (part == 1 ? 0 : 32); it += NGW) {
            if (it < 8) transpose_item(a.in[9] + (size_t)L * 64 * 256, 64, 256, LW, scr, it, lane);
            else if (it < 16) transpose_item(a.in[11] + (size_t)L * 64 * 256, 64, 256, LW + 256 * 64, scr, it - 8, lane);
            else transpose_item(a.in[12] + (size_t)L * 128 * 256, 128, 256, LW + 2 * 256 * 64, scr, it - 16, lane); } }
}
PH_FN void ph_final(const unsigned long long* rss, const float* g, float* dst) {
    const int lane = ltid() & 63, wave = ltid() >> 6;
    f32x4 gg[4];
#pragma unroll
    for (int j = 0; j < 4; ++j) gg[j] = ((const f32x4*)g)[lane + 64 * j];
    for (int m = blockIdx.x * 8 + wave; m < TT; m += gridDim.x * 16) { const int m2 = (m + gridDim.x * 8 < TT) ? m + gridDim.x * 8 : m;
        const float rs = rsqrtf((float)rss[m] * (1.f / (1024.f * 1048576.f)) + 1e-6f), rs2 = rsqrtf((float)rss[m2] * (1.f / (1024.f * 1048576.f)) + 1e-6f);
        f32x4* row = (f32x4*)(dst + (size_t)m * DM); f32x4* row2 = (f32x4*)(dst + (size_t)m2 * DM); f32x4 va[4], vb[4];
#pragma unroll
        for (int j = 0; j < 4; ++j) { va[j] = row[lane + 64 * j]; vb[j] = row2[lane + 64 * j]; }
#pragma unroll
        for (int j = 0; j < 4; ++j) row[lane + 64 * j] = va[j] * rs * gg[j];
        if (m2 != m) {
#pragma unroll
            for (int j = 0; j < 4; ++j) row2[lane + 64 * j] = vb[j] * rs2 * gg[j]; } }
}
PH_FN void ph_pconv(const float* p, bf16_t* dst) {
    const size_t n4 = (size_t)TT * PLE / 4, stride = (size_t)gridDim.x * 512;
    size_t i = (size_t)blockIdx.x * 512 + ltid();
    for (; i + 7 * stride < n4; i += 8 * stride) { f32x4 v[8];
#pragma unroll
        for (int q = 0; q < 8; ++q) v[q] = ((const f32x4*)p)[i + q * stride];
#pragma unroll
        for (int q = 0; q < 8; ++q) { u32x2 w; w.x = pk2(v[q].x, v[q].y); w.y = pk2(v[q].z, v[q].w); ((u32x2*)dst)[i + q * stride] = w; } }
    for (; i < n4; i += stride) { const f32x4 v = ((const f32x4*)p)[i]; u32x2 w; w.x = pk2(v.x, v.y); w.y = pk2(v.z, v.w); ((u32x2*)dst)[i] = w; }
}
__device__ __forceinline__ f32x4 bf4(u32x2 w) { return (f32x4){bflo(w.x), bfhi(w.x), bflo(w.y), bfhi(w.y)}; }
PH_FN void ph_rwkv_prep(ArgsR a, int L, LAS unsigned char* lds) {
    constexpr int ZB_LD = 264, OB_LD = 776;
    LAS bf16_t* zb = (LAS bf16_t*)lds;
    LAS bf16_t* ob = zb + 64 * ZB_LD;
    LAS float* zl = (LAS float*)(ob + 64 * OB_LD);
    const int tid = ltid(), lane = tid & 63, wave = tid >> 6, cq = tid & 63, tg = tid >> 6, c4 = 4 * cq;
    const bf16_t* PJ = (const bf16_t*)(a.ws + WS_PJ);
    bf16_t* RW_R = (bf16_t*)(a.ws + WS_NB); bf16_t* RW_KM = RW_R + (size_t)TT * 256; bf16_t* RW_V = RW_KM + (size_t)TT * 256; bf16_t* RW_KK = RW_V + (size_t)TT * 256;
    bf16_t* RW_LD = (bf16_t*)(a.ws + WS_RWX); bf16_t* RW_B = (bf16_t*)(a.ws + WS_RWX + 16 * MiB); bf16_t* RW_G = (bf16_t*)(a.ws + WS_PJ + 240 * MiB); bf16_t* VT = (bf16_t*)(a.ws + WS_VT);
    unsigned* kmax = (unsigned*)(a.ws + WS_CTL) + 64 + L * 8;
    const float* mu = a.in[7] + L * 1024; const float* w0 = a.in[8] + L * 256; const float* w_up = a.in[9] + L * 64 * 256; const float* a0 = a.in[10] + L * 256;
    const float* a_up = a.in[11] + L * 64 * 256; const float* g_up = a.in[12] + L * 128 * 256; const float* k_k = a.in[13] + L * 256; const float* k_a = a.in[14] + L * 256;
    float mxl0 = 0.f, mxl1 = 0.f;
    for (int u = blockIdx.x; u < TT / 64; u += gridDim.x) {
        const int tok0 = u * 64;
        for (int v8 = tid; v8 < 64 * 32; v8 += 512) { const int t = v8 >> 5, c8 = (v8 & 31) * 8, tok = tok0 + t;
            const u32x4 zc = *(const u32x4*)(PJ + (size_t)tok * INW + C_Z + 768 + c8);
            u32x4 zp = (u32x4){0u, 0u, 0u, 0u}; if ((tok & (SEQ - 1)) != 0) zp = *(const u32x4*)(PJ + (size_t)(tok - 1) * INW + C_Z + 768 + c8);
            const float zv[8] = {bflo(zc.x), bfhi(zc.x), bflo(zc.y), bfhi(zc.y), bflo(zc.z), bfhi(zc.z), bflo(zc.w), bfhi(zc.w)};
            const float pv[8] = {bflo(zp.x), bfhi(zp.x), bflo(zp.y), bfhi(zp.y), bflo(zp.z), bfhi(zp.z), bflo(zp.w), bfhi(zp.w)};
            const f32x4 m0 = *(const f32x4*)(mu + 768 + c8), m1 = *(const f32x4*)(mu + 768 + c8 + 4); const float mv[8] = {m0.x, m0.y, m0.z, m0.w, m1.x, m1.y, m1.z, m1.w};
            float o[8];
#pragma unroll
            for (int q = 0; q < 8; ++q) { float val = zv[q] + mv[q] * (pv[q] - zv[q]);
                if (c8 < 64) val = 1.f - 2.f / (1.f + __expf(2.f * val)); else if (c8 >= 128) val = sigmoidf_(val);
                o[q] = val; }
            *(LAS u32x4*)(zb + t * ZB_LD + c8) = (u32x4){pk2(o[0], o[1]), pk2(o[2], o[3]), pk2(o[4], o[5]), pk2(o[6], o[7])}; }
        asm volatile("" ::: "memory");
        __syncthreads();
        { const int r_ = lane & 31, hh_ = lane >> 5; const bf16_t* LW = (const bf16_t*)(a.ws + WS_LORA);
#pragma unroll
            for (int pr = 0; pr < 3; ++pr) {
                const int nk = (pr == 2) ? 8 : 4, zo = (pr == 0) ? 0 : (pr == 1) ? 64 : 128; const bf16_t* wp = LW + (pr == 0 ? 0 : pr == 1 ? 256 * 64 : 2 * 256 * 64) + (size_t)(32 * wave + r_) * (16 * nk) + 8 * hh_;
                bf16x8s bfr[8];
#pragma unroll
                for (int ks = 0; ks < 8; ++ks) if (ks < nk) bfr[ks] = __builtin_bit_cast(bf16x8s, *(const u32x4*)(wp + 16 * ks));
#pragma unroll
                for (int tb = 0; tb < 2; ++tb) { f32x16 x;
#pragma unroll
                    for (int i = 0; i < 16; ++i) x[i] = 0.f;
                    const LAS bf16_t* ar = zb + (32 * tb + r_) * ZB_LD + 8 * hh_ + zo;
#pragma unroll
                    for (int ks = 0; ks < 8; ++ks) if (ks < nk) x = MFMA32(__builtin_bit_cast(bf16x8s, *(const LAS u32x4*)(ar + 16 * ks)), bfr[ks], x);
#pragma unroll
                    for (int i = 0; i < 16; ++i) ob[(32 * tb + (i & 3) + 8 * (i >> 2) + 4 * hh_) * OB_LD + 256 * pr + 32 * wave + r_] = (bf16_t)f2bf(x[i]); } } }
        asm volatile("" ::: "memory");
        __syncthreads();
        const f32x4 w0v = *(const f32x4*)(w0 + c4), a0v = *(const f32x4*)(a0 + c4);
        { const f32x4 kkc = *(const f32x4*)(k_k + c4), kac = *(const f32x4*)(k_a + c4), mr = *(const f32x4*)(mu + c4), mk = *(const f32x4*)(mu + 256 + c4), mvv = *(const f32x4*)(mu + 512 + c4);
#pragma unroll 1
            for (int tb4 = 0; tb4 < 2; ++tb4) {
              u32x2 lr[4], lk[4], lv[4], lrp[4], lkp[4], lvp[4];
#pragma unroll
              for (int t4 = 0; t4 < 4; ++t4) { const int tok = tok0 + 8 * tg + 4 * tb4 + t4; const bf16_t* zr = PJ + (size_t)tok * INW + C_Z + c4; const bool first = (tok & (SEQ - 1)) == 0;
                lr[t4] = *(const u32x2*)(zr); lk[t4] = *(const u32x2*)(zr + 256); lv[t4] = *(const u32x2*)(zr + 512);
                lrp[t4] = (u32x2){0u, 0u}; lkp[t4] = lrp[t4]; lvp[t4] = lrp[t4];
                if (!first) { lrp[t4] = *(const u32x2*)(zr - INW); lkp[t4] = *(const u32x2*)(zr - INW + 256); lvp[t4] = *(const u32x2*)(zr - INW + 512); } }
#pragma unroll
              for (int t4 = 0; t4 < 4; ++t4) { const int t = 4 * tb4 + t4; const int tok = tok0 + 8 * tg + t; const size_t idx = (size_t)tok * 256 + c4;
                const f32x4 rc = bf4(lr[t4]), kc = bf4(lk[t4]), vc = bf4(lv[t4]), rp = bf4(lrp[t4]), kp = bf4(lkp[t4]), vp = bf4(lvp[t4]);
                const f32x4 r = rc + mr * (rp - rc), k = kc + mk * (kp - kc), v = vc + mvv * (vp - vc);
                f32x4 ld, as, kk, km, bb;
                const LAS bf16_t* orow = ob + (8 * tg + t) * OB_LD + c4; const f32x4 lwv = bf4(*(const LAS u32x2*)orow) + w0v, aav = bf4(*(const LAS u32x2*)(orow + 256)) + a0v, ggv = bf4(*(const LAS u32x2*)(orow + 512));
#pragma unroll
                for (int q = 0; q < 4; ++q) { const float logw = -softplusf_(-lwv[q]) - 0.5f; ld[q] = -__expf(logw); as[q] = sigmoidf_(aav[q]); }
                kk = k * kkc; const float n2 = allred16((kk.x * kk.x + kk.y * kk.y) + (kk.z * kk.z + kk.w * kk.w)); kk = kk * (1.f / fmaxf(sqrtf(n2), 1e-12f));
                km = k * (1.f + (as - 1.f) * kac); bb = kk * as;
                *(u32x2*)(RW_R + idx) = (u32x2){pk2(r.x, r.y), pk2(r.z, r.w)}; *(u32x2*)(RW_KM + idx) = (u32x2){pk2(km.x, km.y), pk2(km.z, km.w)}; *(u32x2*)(RW_V + idx) = (u32x2){pk2(v.x, v.y), pk2(v.z, v.w)};
                *(u32x2*)(RW_KK + idx) = (u32x2){pk2(kk.x, kk.y), pk2(kk.z, kk.w)}; *(u32x2*)(RW_B + idx) = (u32x2){pk2(bb.x, bb.y), pk2(bb.z, bb.w)}; *(u32x2*)(RW_LD + idx) = (u32x2){pk2(ld.x, ld.y), pk2(ld.z, ld.w)};
                *(u32x2*)(RW_G + idx) = (u32x2){pk2(ggv.x, ggv.y), pk2(ggv.z, ggv.w)}; } } }
        { const int b = tok0 / SEQ; float n2m = 0.f;
#pragma unroll
            for (int tt = 0; tt < 8; ++tt) { const f32x4 kv = bf4(*(const u32x2*)(PJ + (size_t)(tok0 + 8 * wave + tt) * INW + C_SK + 4 * lane));
                n2m = fmaxf(n2m, allred16((kv.x * kv.x + kv.y * kv.y) + (kv.z * kv.z + kv.w * kv.w))); }
            if (b == 0) mxl0 = fmaxf(mxl0, n2m); else mxl1 = fmaxf(mxl1, n2m); }
        { const int col = tid & 255, b = tok0 / SEQ; unsigned short e[4][8];
#pragma unroll
            for (int it = 0; it < 4; ++it) { const int th = (tid >> 8) + 2 * it;
#pragma unroll
                for (int t = 0; t < 8; ++t) e[it][t] = PJ[(size_t)(tok0 + th * 8 + t) * INW + C_SV + col]; }
#pragma unroll
            for (int it = 0; it < 4; ++it) { const int th = (tid >> 8) + 2 * it, s0 = (tok0 & (SEQ - 1)) + th * 8;
                u32x4 o; o.x = e[it][0] | ((unsigned)e[it][1] << 16); o.y = e[it][2] | ((unsigned)e[it][3] << 16); o.z = e[it][4] | ((unsigned)e[it][5] << 16); o.w = e[it][6] | ((unsigned)e[it][7] << 16);
                *(u32x4*)(VT + ((size_t)((b * 4 + (col >> 6)) * 64 + (col & 63))) * SEQ + s0) = o; } }
        __syncthreads();
    }
    if ((lane & 15) == 0) { zl[wave * 8 + (lane >> 4)] = mxl0; zl[wave * 8 + 4 + (lane >> 4)] = mxl1; }
    __syncthreads();
    if (tid < 8) { float m = 0.f;
#pragma unroll
        for (int w_ = 0; w_ < 8; ++w_) m = fmaxf(m, zl[w_ * 8 + tid]);
        atomicMax(kmax + tid, __float_as_uint(m)); }
    __syncthreads();
}
typedef float f32x2 __attribute__((ext_vector_type(2)));
constexpr int SC_NC = 32, SC_LEN = SEQ / SC_NC;
struct ScOps { f32x4 r, w, km, kk, b, vv; };
template <int NR> __device__ __forceinline__ ScOps sc_ld(const LAS float* p, int j4, int rowA) { ScOps o; o.r = *(const LAS f32x4*)(p + j4); o.w = *(const LAS f32x4*)(p + 64 + j4); o.km = *(const LAS f32x4*)(p + 128 + j4);
    o.kk = *(const LAS f32x4*)(p + 192 + j4); o.b = *(const LAS f32x4*)(p + 256 + j4);
    if (NR == 4) o.vv = *(const LAS f32x4*)(p + 320 + rowA); else { const f32x2 v2 = *(const LAS f32x2*)(p + 320 + rowA); o.vv = (f32x4){v2.x, v2.y, 0.f, 0.f}; } return o; }
template <int NR, bool REAL, bool YOUT> __device__ __forceinline__ void sc_step(const ScOps& o, f32x2 (&S)[4][2], LAS float* yp) {
    const f32x2 kk01 = o.kk.xy, kk23 = o.kk.zw, w01 = o.w.xy, w23 = o.w.zw, bb01 = o.b.xy, bb23 = o.b.zw, km01 = o.km.xy, km23 = o.km.zw;
    float sa[4];
#pragma unroll
    for (int c = 0; c < NR; ++c) { const f32x2 pa = S[c][0] * kk01 + S[c][1] * kk23; sa[c] = -allred16(pa.x + pa.y); }
#pragma unroll
    for (int c = 0; c < NR; ++c) { f32x2 t01 = bb01 * sa[c], t23 = bb23 * sa[c];
        if (REAL) { t01 += km01 * o.vv[c]; t23 += km23 * o.vv[c]; }
        S[c][0] = S[c][0] * w01 + t01; S[c][1] = S[c][1] * w23 + t23; }
    if (YOUT) { const f32x2 r01 = o.r.xy, r23 = o.r.zw; f32x4 y = {0.f, 0.f, 0.f, 0.f};
#pragma unroll
        for (int c = 0; c < NR; ++c) { const f32x2 q = S[c][0] * r01 + S[c][1] * r23; y[c] = allred16(q.x + q.y); }
        if (NR == 4) *(LAS f32x4*)yp = y; else *(LAS f32x2*)yp = y.xy; }
}
template <int NR, bool REAL, bool YOUT> __device__ __forceinline__ void sc_chunk(const LAS float* bb, int j4, int rowA, f32x2 (&S)[4][2], LAS float* yb) {
    ScOps oa = sc_ld<NR>(bb, j4, rowA);
#pragma unroll 2
    for (int s = 0; s < 32; s += 2) {
        const ScOps ob = sc_ld<NR>(bb + (s + 1) * 384, j4, rowA);
        sc_step<NR, REAL, YOUT>(oa, S, yb + s * 64 + rowA);
        oa = sc_ld<NR>(bb + (s + 2) * 384, j4, rowA);
        sc_step<NR, REAL, YOUT>(ob, S, yb + (s + 1) * 64 + rowA);
    }
}
template <int PASS> PH_FN void ph_scan_pass(ArgsR a, LAS unsigned char* lds, int unit, int L) {
    const int tid = ltid(), lane = tid & 63, wave = tid >> 6, rg = lane >> 4, j = lane & 15, j4 = 4 * j;
    int bh, c; const int kind = (PASS == 1) ? (wave >> 2) : 0;
    if (PASS == 1) { bh = unit / (SC_NC - 1); c = unit % (SC_NC - 1); } else { bh = unit / SC_NC; c = unit % SC_NC; }
    const int b = bh >> 2, h = bh & 3, t0 = c * SC_LEN;
    constexpr int NR = (PASS == 1) ? 4 : 2;
    const int rowA = (PASS == 1) ? (wave & 3) * 16 + 4 * rg : wave * 8 + 2 * rg;
    const bool active = true;
    const bf16_t* RW_R = (const bf16_t*)(a.ws + WS_NB); const bf16_t* RW_KM = RW_R + (size_t)TT * 256; const bf16_t* RW_V = RW_KM + (size_t)TT * 256; const bf16_t* RW_KK = RW_V + (size_t)TT * 256;
    const bf16_t* RW_LD = (const bf16_t*)(a.ws + WS_RWX); const bf16_t* RW_B = (const bf16_t*)(a.ws + WS_RWX + 16 * MiB);
    float* HP = (float*)(a.ws + WS_HP); const float* SC = (const float*)(a.ws + WS_SC);
    bf16_t* MX = (bf16_t*)(a.ws + WS_MX);
    LAS float* buf0 = (LAS float*)lds; LAS float* ybuf = buf0 + 2 * 32 * 384;
    const int st = tid >> 4, c4 = (tid & 15) * 4;
    const size_t gbase = ((size_t)b * SEQ + t0) * 256 + h * 64 + c4;
    u32x2 pr, pkm, pkk, pb, pv, pw;
#define SC_LOAD(ch) do { const size_t g_ = gbase + (size_t)((ch) * 32 + st) * 256; pr = *(const u32x2*)(RW_R + g_); pkm = *(const u32x2*)(RW_KM + g_); pkk = *(const u32x2*)(RW_KK + g_); \
        pb = *(const u32x2*)(RW_B + g_); pv = *(const u32x2*)(RW_V + g_); pw = *(const u32x2*)(RW_LD + g_); } while (0)
#define SC_UNP(w) ((f32x4){bflo((w).x), bfhi((w).x), bflo((w).y), bfhi((w).y)})
#define SC_STORE(bufi) do { LAS float* d_ = buf0 + (bufi) * (32 * 384) + st * 384 + c4; *(LAS f32x4*)(d_) = SC_UNP(pr); { const f32x4 l_ = SC_UNP(pw); *(LAS f32x4*)(d_ + 64) = (f32x4){__expf(l_.x), __expf(l_.y), __expf(l_.z), __expf(l_.w)}; } *(LAS f32x4*)(d_ + 128) = SC_UNP(pkm); \
        *(LAS f32x4*)(d_ + 192) = SC_UNP(pkk); *(LAS f32x4*)(d_ + 256) = SC_UNP(pb); *(LAS f32x4*)(d_ + 320) = SC_UNP(pv); } while (0)
    const int fs_ = tid >> 4, fr4_ = (tid & 15) * 4; const bf16_t* RW_G = (const bf16_t*)(a.ws + WS_PJ + 240 * MiB);
    f32x4 rk4 = {0.f, 0.f, 0.f, 0.f}, lw4 = rk4, lb4 = rk4; u32x2 fr_ = {0u, 0u}, fkm_ = fr_, fv_ = fr_, fg_ = fr_;
    if (PASS == 2) { rk4 = *(const f32x4*)(a.in[15] + L * 256 + h * 64 + fr4_); lw4 = *(const f32x4*)(a.in[16] + L * 256 + h * 64 + fr4_); lb4 = *(const f32x4*)(a.in[17] + L * 256 + h * 64 + fr4_); }
#define SC_FPRE(chp) do { const size_t i_ = ((size_t)b * SEQ + t0 + (chp) * 32 + fs_) * 256 + h * 64 + fr4_; fr_ = *(const u32x2*)(RW_R + i_); fkm_ = *(const u32x2*)(RW_KM + i_); fv_ = *(const u32x2*)(RW_V + i_); fg_ = *(const u32x2*)(RW_G + i_); } while (0)
#define SC_FLUSH(chp) do { const f32x4 y_ = *(const LAS f32x4*)(ybuf + ((chp) & 1) * 2048 + fs_ * 64 + fr4_); const f32x4 r_ = bf4(fr_), km_ = bf4(fkm_), v_ = bf4(fv_), g_ = bf4(fg_); \
        const float mean_ = allred16((y_.x + y_.y) + (y_.z + y_.w)) * (1.f / 64.f); const f32x4 d_ = y_ - mean_; const float var_ = allred16((d_.x * d_.x + d_.y * d_.y) + (d_.z * d_.z + d_.w * d_.w)) * (1.f / 64.f); \
        const f32x4 t_ = r_ * km_ * rk4; const float bon_ = allred16((t_.x + t_.y) + (t_.z + t_.w)); const f32x4 o_ = (d_ * rsqrtf(var_ + 64e-5f) * lw4 + lb4 + v_ * bon_) * g_; \
        *(u32x2*)(MX + ((size_t)b * SEQ + t0 + (chp) * 32 + fs_) * 1024 + 768 + h * 64 + fr4_) = (u32x2){pk2(o_.x, o_.y), pk2(o_.z, o_.w)}; } while (0)
    f32x2 S[4][2];
#pragma unroll
    for (int q = 0; q < 4; ++q) { S[q][0] = (f32x2){0.f, 0.f}; S[q][1] = (f32x2){0.f, 0.f}; }
    if (PASS == 1) { if (kind == 1) {
#pragma unroll
            for (int q = 0; q < 4; ++q) { S[q][0].x = (j4 == rowA + q) ? 1.f : 0.f; S[q][0].y = (j4 + 1 == rowA + q) ? 1.f : 0.f; S[q][1].x = (j4 + 2 == rowA + q) ? 1.f : 0.f; S[q][1].y = (j4 + 3 == rowA + q) ? 1.f : 0.f; } } }
    else if (c > 0) { const float* sp = SC + ((size_t)(bh * SC_NC + c)) * 4096;
#pragma unroll
        for (int q = 0; q < NR; ++q) { const f32x4 sv = *(const f32x4*)(sp + (rowA + q) * 64 + j4); S[q][0] = sv.xy; S[q][1] = sv.zw; } }
    SC_LOAD(0); SC_STORE(0); __syncthreads();
    constexpr int NRC = SC_LEN / 32;
    for (int ch = 0; ch < NRC; ++ch) {
        if (ch + 1 < NRC) SC_LOAD(ch + 1);
        if (PASS == 2 && ch > 0) SC_FLUSH(ch - 1);
        if (PASS == 2) SC_FPRE(ch);
        const LAS float* bb = buf0 + (ch & 1) * (32 * 384); LAS float* yb = ybuf + (ch & 1) * 2048;
        if (active) {
            if (PASS == 2) sc_chunk<2, true, true>(bb, j4, rowA, S, yb);
            else if (kind == 0) sc_chunk<4, true, false>(bb, j4, rowA, S, yb);
            else sc_chunk<4, false, false>(bb, j4, rowA, S, yb);
        }
        if (ch + 1 < NRC) SC_STORE((ch + 1) & 1);
        __syncthreads();
    }
    if (PASS == 2) SC_FLUSH(NRC - 1);
    else { float* hp = HP + ((size_t)((bh * (SC_NC - 1) + c) * 2 + kind)) * 4096;
#pragma unroll
        for (int q = 0; q < 4; ++q) *(f32x4*)(hp + (rowA + q) * 64 + j4) = (f32x4){S[q][0].x, S[q][0].y, S[q][1].x, S[q][1].y}; }
    __syncthreads();
#undef SC_LOAD
#undef SC_UNP
#undef SC_STORE
#undef SC_FLUSH
#undef SC_FPRE
}
PH_FN void ph_scan_combine(ArgsR a, LAS unsigned char* lds, int unit) {
    LAS float* Ss = (LAS float*)lds; LAS float* Ps = Ss + 16 * 64;
    const float* HP = (const float*)(a.ws + WS_HP); float* SC = (float*)(a.ws + WS_SC);
    const int bh = unit >> 2, v0 = (unit & 3) * 16;
    const int tid = ltid(), v = tid >> 5, k2 = (tid & 31) * 2;
    float s0 = 0.f, s1 = 0.f;
    const float* Hc = HP + ((size_t)(bh * (SC_NC - 1) * 2)) * 4096;
    f32x4 p0 = *(const f32x4*)(Hc + 4096 + tid * 8), p1 = *(const f32x4*)(Hc + 4096 + tid * 8 + 4); f32x2 hv = *(const f32x2*)(Hc + (v0 + v) * 64 + k2);
    for (int c = 0; c < SC_NC - 1; ++c) {
        *(LAS f32x4*)(Ps + tid * 8) = p0; *(LAS f32x4*)(Ps + tid * 8 + 4) = p1; *(LAS f32x2*)(Ss + v * 64 + k2) = (f32x2){s0, s1};
        float n0 = hv.x, n1 = hv.y;
        if (c + 1 < SC_NC - 1) { const float* Hn = Hc + (size_t)(c + 1) * 8192; p0 = *(const f32x4*)(Hn + 4096 + tid * 8); p1 = *(const f32x4*)(Hn + 4096 + tid * 8 + 4); hv = *(const f32x2*)(Hn + (v0 + v) * 64 + k2); }
        __syncthreads();
        float n2_ = 0.f, n3_ = 0.f;
#pragma unroll
        for (int m = 0; m < 64; m += 4) { const f32x4 sv = *(const LAS f32x4*)(Ss + v * 64 + m); const f32x2 q0 = *(const LAS f32x2*)(Ps + m * 64 + k2), q1 = *(const LAS f32x2*)(Ps + (m + 1) * 64 + k2), q2 = *(const LAS f32x2*)(Ps + (m + 2) * 64 + k2), q3 = *(const LAS f32x2*)(Ps + (m + 3) * 64 + k2);
            n0 += sv.x * q0.x; n1 += sv.x * q0.y; n2_ += sv.y * q1.x; n3_ += sv.y * q1.y; n0 += sv.z * q2.x; n1 += sv.z * q2.y; n2_ += sv.w * q3.x; n3_ += sv.w * q3.y; }
        n0 += n2_; n1 += n3_;
        s0 = n0; s1 = n1;
        *(f32x2*)(SC + ((size_t)(bh * SC_NC + c + 1)) * 4096 + (v0 + v) * 64 + k2) = (f32x2){s0, s1};
        __syncthreads();
    }
}
PH_FN void ph_ret_scan(ArgsR a, int u) {
    bf16_t* KV = (bf16_t*)(a.ws + WS_KV);
    const int e2 = u * 512 + ltid();
    const int bh = e2 >> 11, within = (e2 & 2047) * 2, h = bh & 7;
    const float g64 = __expf(64.f * ret_logg(h));
    bf16_t* p = KV + (size_t)bh * 256 * 4096 + within;
    float s0 = 0.f, s1 = 0.f;
    for (int c0 = 0; c0 < 256; c0 += 32) { unsigned x[32];
#pragma unroll
        for (int q = 0; q < 32; ++q) x[q] = *(const unsigned*)(p + (size_t)(c0 + q) * 4096);
#pragma unroll
        for (int q = 0; q < 32; ++q) { *(unsigned*)(p + (size_t)(c0 + q) * 4096) = pk2(s0, s1); s0 = s0 * g64 + bflo(x[q]); s1 = s1 * g64 + bfhi(x[q]); } }
}
__device__ __forceinline__ bf16x8s sb_pack8(float w0, float w1, float w2, float w3, float w4, float w5, float w6, float w7) {
    u32x4 pk; pk.x = pk2(w0, w1); pk.y = pk2(w2, w3); pk.z = pk2(w4, w5); pk.w = pk2(w6, w7); return __builtin_bit_cast(bf16x8s, pk); }
__device__ __forceinline__ float sb_pairsum(float x) { const unsigned xi = __float_as_uint(x); const auto rr = __builtin_amdgcn_permlane32_swap(xi, xi, false, false); return __uint_as_float(rr[0]) + __uint_as_float(rr[1]); }
PH_FN void ph_sb(ArgsR a, int L, int first, int nblk) {
    const bf16_t* PJ = (const bf16_t*)(a.ws + WS_PJ); const bf16_t* VT = (const bf16_t*)(a.ws + WS_VT); bf16_t* MX = (bf16_t*)(a.ws + WS_MX);
    const unsigned* kmax = (const unsigned*)(a.ws + WS_CTL) + 64 + L * 8;
    const int tid = ltid(), lane = tid & 63, wave = tid >> 6, r = lane & 31, hh = lane >> 5;
    for (int u = first; u < 512; u += nblk) {
        const int bh = u & 7, qi = (63 - (u >> 3)) * 8 + wave, b = bh >> 2, h = bh & 3, q0 = qi * 32;
        bf16x8s bq[4]; float qn2 = 0.f;
        { const bf16_t* qp = PJ + ((size_t)b * SEQ + q0 + r) * INW + C_SQ + h * 64 + 8 * hh;
#pragma unroll
            for (int ks = 0; ks < 4; ++ks) { const u32x4 w = *(const u32x4*)(qp + 16 * ks); bq[ks] = __builtin_bit_cast(bf16x8s, w);
                qn2 += bflo(w.x) * bflo(w.x) + bfhi(w.x) * bfhi(w.x) + bflo(w.y) * bflo(w.y) + bfhi(w.y) * bfhi(w.y) + bflo(w.z) * bflo(w.z) + bfhi(w.z) * bfhi(w.z) + bflo(w.w) * bflo(w.w) + bfhi(w.w) * bfhi(w.w); } }
        qn2 = sb_pairsum(qn2);
        const float bound = sqrtf(qn2) * 0.125f * sqrtf(__uint_as_float(kmax[bh])) * 1.001f + 1e-3f;
        f32x16 o0, o1;
#pragma unroll
        for (int i = 0; i < 16; ++i) { o0[i] = 0.f; o1[i] = 0.f; }
        float after = 0.f;
        u32x4 nk_[4]; u32x2 nlo[2][2], nhi[2][2];
#define SB_LOADT(k0_) do { const int kc_ = (k0_) >= 0 ? (k0_) : 0; const bf16_t* kp_ = PJ + ((size_t)b * SEQ + kc_ + r) * INW + C_SK + h * 64 + 8 * hh; \
            _Pragma("unroll") for (int ks = 0; ks < 4; ++ks) nk_[ks] = *(const u32x4*)(kp_ + 16 * ks); \
            const bf16_t* vt_ = VT + ((size_t)(bh * 64 + r)) * SEQ + kc_ + 4 * hh; \
            _Pragma("unroll") for (int s = 0; s < 2; ++s) _Pragma("unroll") for (int dh = 0; dh < 2; ++dh) { nlo[s][dh] = *(const u32x2*)(vt_ + (size_t)dh * 32 * SEQ + 16 * s); nhi[s][dh] = *(const u32x2*)(vt_ + (size_t)dh * 32 * SEQ + 16 * s + 8); } } while (0)
        SB_LOADT(q0);
        for (int k0 = q0; k0 >= 0; k0 -= 32) {
            bf16x8s ak[4], pb[2][2];
#pragma unroll
            for (int ks = 0; ks < 4; ++ks) ak[ks] = __builtin_bit_cast(bf16x8s, nk_[ks]);
#pragma unroll
            for (int s = 0; s < 2; ++s)
#pragma unroll
                for (int dh = 0; dh < 2; ++dh) pb[s][dh] = __builtin_bit_cast(bf16x8s, (u32x4){nlo[s][dh].x, nlo[s][dh].y, nhi[s][dh].x, nhi[s][dh].y});
            SB_LOADT(k0 - 32);
            f32x16 x;
#pragma unroll
            for (int i = 0; i < 16; ++i) x[i] = 0.f;
#pragma unroll
            for (int ks = 0; ks < 4; ++ks) x = MFMA32(ak[ks], bq[ks], x);
            const bool diag = (k0 == q0);
            float z[16], ls[16], w[16];
#pragma unroll
            for (int i = 0; i < 16; ++i) { z[i] = x[i] * 0.125f; const bool valid = !diag || (((i & 3) + 8 * (i >> 2) + 4 * hh) < r); ls[i] = valid ? -softplusf_(z[i]) : 0.f; }
            float acc = after;
#pragma unroll
            for (int g = 3; g >= 0; --g) { const float G = (ls[4 * g] + ls[4 * g + 1]) + (ls[4 * g + 2] + ls[4 * g + 3]); const float tot = sb_pairsum(G);
                const float base = acc + (hh == 0 ? tot - G : 0.f);
                const float c3 = base + ls[4 * g + 3], c2 = c3 + ls[4 * g + 2], c1 = c2 + ls[4 * g + 1], c0 = c1 + ls[4 * g];
                w[4 * g + 3] = __expf(z[4 * g + 3] + c3); w[4 * g + 2] = __expf(z[4 * g + 2] + c2); w[4 * g + 1] = __expf(z[4 * g + 1] + c1); w[4 * g] = __expf(z[4 * g] + c0);
                acc += tot; }
            after = acc;
            if (diag) {
#pragma unroll
                for (int i = 0; i < 16; ++i) if (!(((i & 3) + 8 * (i >> 2) + 4 * hh) < r)) w[i] = 0.f; }
            const bf16x8s xs0 = sb_pack8(w[0], w[1], w[2], w[3], w[4], w[5], w[6], w[7]), xs1 = sb_pack8(w[8], w[9], w[10], w[11], w[12], w[13], w[14], w[15]);
            o0 = MFMA32(xs0, pb[0][0], o0); o0 = MFMA32(xs1, pb[1][0], o0); o1 = MFMA32(xs0, pb[0][1], o1); o1 = MFMA32(xs1, pb[1][1], o1);
            if (__all((after + bound < -104.f) ? 1 : 0)) break;
        }
        bf16_t* op = MX + ((size_t)b * SEQ + q0) * 1024 + 512 + h * 64 + r;
#pragma unroll
        for (int i = 0; i < 16; ++i) { const int qr = (i & 3) + 8 * (i >> 2) + 4 * hh; op[(size_t)qr * 1024] = (bf16_t)f2bf(o0[i]); op[(size_t)qr * 1024 + 32] = (bf16_t)f2bf(o1[i]); }
    }
}
__device__ __forceinline__ void rk_unp8(u32x4 w, float (&f)[8]) { f[0] = bflo(w.x); f[1] = bfhi(w.x); f[2] = bflo(w.y); f[3] = bfhi(w.y); f[4] = bflo(w.z); f[5] = bfhi(w.z); f[6] = bflo(w.w); f[7] = bfhi(w.w); }
PH_FN void ph_ret_kv(ArgsR a, LAS unsigned char* lds) {
    bf16_t* PJ = (bf16_t*)(a.ws + WS_PJ); bf16_t* KV = (bf16_t*)(a.ws + WS_KV);
    const float* cosT = (const float*)(a.ws + WS_ROPE); const float* sinT = cosT + SEQ * 32;
    const int tid = ltid(), lane = tid & 63, wave = tid >> 6, r = lane & 31, hh = lane >> 5;
    LAS bf16_t* kdt = (LAS bf16_t*)(lds + wave * 17408); LAS bf16_t* vtl = kdt + 64 * 68;
    for (int cu = blockIdx.x * 8 + wave; cu < 4096; cu += gridDim.x * 8) {
        const int b = cu >> 11, c = (cu >> 3) & 255, h = cu & 7, tok0 = b * SEQ + c * 64;
        const float lg = ret_logg(h), dk = __expf((float)(63 - lane) * lg);
        bf16_t* qp = PJ + (size_t)(tok0 + lane) * INW + C_RQ + h * 64; bf16_t* kp = PJ + (size_t)(tok0 + lane) * INW + C_RK + h * 64; const bf16_t* vp = PJ + (size_t)(tok0 + lane) * INW + C_RV + h * 64;
        const float* cp = cosT + (size_t)(c * 64 + lane) * 32; const float* sp = sinT + (size_t)(c * 64 + lane) * 32;
        f32x4 c0a[4], c1a[4], s0a[4], s1a[4]; u32x4 kla[4], kha[4], qla[4], qha[4];
#pragma unroll
        for (int g = 0; g < 4; ++g) { c0a[g] = *(const f32x4*)(cp + 8 * g); c1a[g] = *(const f32x4*)(cp + 8 * g + 4); s0a[g] = *(const f32x4*)(sp + 8 * g); s1a[g] = *(const f32x4*)(sp + 8 * g + 4);
            kla[g] = *(const u32x4*)(kp + 8 * g); kha[g] = *(const u32x4*)(kp + 32 + 8 * g); qla[g] = *(const u32x4*)(qp + 8 * g); qha[g] = *(const u32x4*)(qp + 32 + 8 * g); }
        u32x4 vra[8];
#pragma unroll
        for (int q = 0; q < 8; ++q) vra[q] = *(const u32x4*)(vp + 8 * q);
#pragma unroll
        for (int g = 0; g < 4; ++g) {
            const f32x4 c0 = c0a[g], c1 = c1a[g], s0 = s0a[g], s1 = s1a[g];
            const float cs[8] = {c0.x, c0.y, c0.z, c0.w, c1.x, c1.y, c1.z, c1.w}, sn[8] = {s0.x, s0.y, s0.z, s0.w, s1.x, s1.y, s1.z, s1.w};
            float k1[8], k2[8], q1[8], q2[8];
            rk_unp8(kla[g], k1); rk_unp8(kha[g], k2); rk_unp8(qla[g], q1); rk_unp8(qha[g], q2);
            unsigned ka[8], kb[8]; float qa[8], qb[8];
#pragma unroll
            for (int t = 0; t < 8; ++t) { ka[t] = f2bf((k1[t] * cs[t] - k2[t] * sn[t]) * 0.125f); kb[t] = f2bf((k1[t] * sn[t] + k2[t] * cs[t]) * 0.125f); qa[t] = q1[t] * cs[t] - q2[t] * sn[t]; qb[t] = q1[t] * sn[t] + q2[t] * cs[t]; }
            *(u32x4*)(kp + 8 * g) = (u32x4){ka[0] | (ka[1] << 16), ka[2] | (ka[3] << 16), ka[4] | (ka[5] << 16), ka[6] | (ka[7] << 16)};
            *(u32x4*)(kp + 32 + 8 * g) = (u32x4){kb[0] | (kb[1] << 16), kb[2] | (kb[3] << 16), kb[4] | (kb[5] << 16), kb[6] | (kb[7] << 16)};
            *(u32x4*)(qp + 8 * g) = (u32x4){pk2(qa[0], qa[1]), pk2(qa[2], qa[3]), pk2(qa[4], qa[5]), pk2(qa[6], qa[7])};
            *(u32x4*)(qp + 32 + 8 * g) = (u32x4){pk2(qb[0], qb[1]), pk2(qb[2], qb[3]), pk2(qb[4], qb[5]), pk2(qb[6], qb[7])};
#pragma unroll
            for (int t = 0; t < 8; ++t) { kdt[(8 * g + t) * 68 + lane] = (bf16_t)f2bf(__uint_as_float(ka[t] << 16) * dk); kdt[(32 + 8 * g + t) * 68 + lane] = (bf16_t)f2bf(__uint_as_float(kb[t] << 16) * dk); }
        }
#pragma unroll
        for (int q = 0; q < 8; ++q) { const u32x4 w = vra[q]; LAS bf16_t* d = vtl + (8 * q) * 68 + lane;
            d[0] = (bf16_t)(w.x & 0xffffu); d[68] = (bf16_t)(w.x >> 16); d[2 * 68] = (bf16_t)(w.y & 0xffffu); d[3 * 68] = (bf16_t)(w.y >> 16);
            d[4 * 68] = (bf16_t)(w.z & 0xffffu); d[5 * 68] = (bf16_t)(w.z >> 16); d[6 * 68] = (bf16_t)(w.w & 0xffffu); d[7 * 68] = (bf16_t)(w.w >> 16); }
        asm volatile("" ::: "memory");
        bf16_t* outp = KV + ((size_t)((b * 8 + h) * 256 + c)) * 4096;
#pragma unroll
        for (int db = 0; db < 2; ++db)
#pragma unroll
            for (int eb = 0; eb < 2; ++eb) { f32x16 x;
#pragma unroll
                for (int i = 0; i < 16; ++i) x[i] = 0.f;
#pragma unroll
                for (int ks = 0; ks < 4; ++ks) { const LAS bf16_t* ap = kdt + (32 * db + r) * 68 + 16 * ks + 8 * hh; const LAS bf16_t* bp = vtl + (32 * eb + r) * 68 + 16 * ks + 8 * hh;
                    const u32x2 a0 = *(const LAS u32x2*)ap, a1 = *(const LAS u32x2*)(ap + 4), b0 = *(const LAS u32x2*)bp, b1 = *(const LAS u32x2*)(bp + 4);
                    x = MFMA32(__builtin_bit_cast(bf16x8s, (u32x4){a0.x, a0.y, a1.x, a1.y}), __builtin_bit_cast(bf16x8s, (u32x4){b0.x, b0.y, b1.x, b1.y}), x); }
#pragma unroll
                for (int gq = 0; gq < 4; ++gq) *(u32x2*)(outp + (size_t)(32 * eb + r) * 64 + 32 * db + 8 * gq + 4 * hh) = (u32x2){pk2(x[4 * gq], x[4 * gq + 1]), pk2(x[4 * gq + 2], x[4 * gq + 3])}; }
        asm volatile("" ::: "memory");
    }
}
PH_FN void ph_ret_out(ArgsR a, int L, LAS unsigned char* lds) {
    const bf16_t* PJ = (const bf16_t*)(a.ws + WS_PJ); const bf16_t* KV = (const bf16_t*)(a.ws + WS_KV); bf16_t* MX = (bf16_t*)(a.ws + WS_MX);
    const float* ng = a.in[6] + L * 512;
    const int tid = ltid(), lane = tid & 63, wave = tid >> 6, r = lane & 31, hh = lane >> 5;
    LAS bf16_t* vtl = (LAS bf16_t*)(lds + wave * 9216);
    for (int cu = blockIdx.x * 8 + wave; cu < 4096; cu += gridDim.x * 8) {
        const int b = cu >> 11, c = (cu >> 3) & 255, h = cu & 7, tok0 = b * SEQ + c * 64;
        const float lg = ret_logg(h);
        { const bf16_t* vp = PJ + (size_t)(tok0 + lane) * INW + C_RV + h * 64;
#pragma unroll
            for (int q = 0; q < 8; ++q) { const u32x4 w = *(const u32x4*)(vp + 8 * q); LAS bf16_t* d = vtl + (8 * q) * 68 + lane;
                d[0] = (bf16_t)(w.x & 0xffffu); d[68] = (bf16_t)(w.x >> 16); d[2 * 68] = (bf16_t)(w.y & 0xffffu); d[3 * 68] = (bf16_t)(w.y >> 16);
                d[4 * 68] = (bf16_t)(w.z & 0xffffu); d[5 * 68] = (bf16_t)(w.z >> 16); d[6 * 68] = (bf16_t)(w.w & 0xffffu); d[7 * 68] = (bf16_t)(w.w >> 16); } }
        asm volatile("" ::: "memory");
        const bf16_t* Rt = KV + ((size_t)((b * 8 + h) * 256 + c)) * 4096;
        const float ng0 = ng[h * 64 + r], ng1 = ng[h * 64 + 32 + r];
#pragma unroll 1
        for (int qh = 0; qh < 2; ++qh) {
            bf16x8s bq[4];
            { const bf16_t* qp = PJ + (size_t)(tok0 + 32 * qh + r) * INW + C_RQ + h * 64 + 8 * hh;
#pragma unroll
                for (int ks = 0; ks < 4; ++ks) bq[ks] = __builtin_bit_cast(bf16x8s, *(const u32x4*)(qp + 16 * ks)); }
            unsigned short gq0[16], gq1[16];
#pragma unroll
            for (int i = 0; i < 16; ++i) { const size_t tk = (size_t)tok0 + 32 * qh + (i & 3) + 8 * (i >> 2) + 4 * hh; gq0[i] = PJ[tk * INW + C_RG + h * 64 + r]; gq1[i] = PJ[tk * INW + C_RG + h * 64 + 32 + r]; }
            f32x16 o0, o1, oc0, oc1;
#pragma unroll
            for (int i = 0; i < 16; ++i) { o0[i] = 0.f; o1[i] = 0.f; oc0[i] = 0.f; oc1[i] = 0.f; }
#pragma unroll
            for (int kh = 0; kh < 2; ++kh) {
                bf16x8s ak[4];
                { const bf16_t* kp = PJ + (size_t)(tok0 + 32 * kh + r) * INW + C_RK + h * 64 + 8 * hh;
#pragma unroll
                    for (int ks = 0; ks < 4; ++ks) ak[ks] = __builtin_bit_cast(bf16x8s, *(const u32x4*)(kp + 16 * ks)); }
                f32x16 x;
#pragma unroll
                for (int i = 0; i < 16; ++i) x[i] = 0.f;
#pragma unroll
                for (int ks = 0; ks < 4; ++ks) x = MFMA32(ak[ks], bq[ks], x);
                float w[16];
#pragma unroll
                for (int i = 0; i < 16; ++i) { const int j = 32 * kh + (i & 3) + 8 * (i >> 2) + 4 * hh; w[i] = x[i] * __expf(lg * fabsf((float)(32 * qh + r - j))); }
                const bf16x8s xs0 = sb_pack8(w[0], w[1], w[2], w[3], w[4], w[5], w[6], w[7]), xs1 = sb_pack8(w[8], w[9], w[10], w[11], w[12], w[13], w[14], w[15]);
                bf16x8s pb[2][2];
#pragma unroll
                for (int s = 0; s < 2; ++s)
#pragma unroll
                    for (int dh = 0; dh < 2; ++dh) { const LAS bf16_t* vq = vtl + (32 * dh + r) * 68 + 32 * kh + 16 * s + 4 * hh; const u32x2 lo = *(const LAS u32x2*)(vq), hi = *(const LAS u32x2*)(vq + 8);
                        pb[s][dh] = __builtin_bit_cast(bf16x8s, (u32x4){lo.x, lo.y, hi.x, hi.y}); }
                o0 = MFMA32(xs0, pb[0][0], o0); o0 = MFMA32(xs1, pb[1][0], o0); o1 = MFMA32(xs0, pb[0][1], o1); o1 = MFMA32(xs1, pb[1][1], o1);
            }
#pragma unroll
            for (int ks = 0; ks < 4; ++ks) { const bf16x8s r0 = __builtin_bit_cast(bf16x8s, *(const u32x4*)(Rt + (size_t)r * 64 + 16 * ks + 8 * hh)), r1 = __builtin_bit_cast(bf16x8s, *(const u32x4*)(Rt + (size_t)(32 + r) * 64 + 16 * ks + 8 * hh));
                oc0 = MFMA32(bq[ks], r0, oc0); oc1 = MFMA32(bq[ks], r1, oc1); }
#pragma unroll
            for (int i = 0; i < 16; ++i) { const int qi = 32 * qh + (i & 3) + 8 * (i >> 2) + 4 * hh; const float f = __expf((float)(qi + 1) * lg);
                const float v0 = o0[i] + f * oc0[i], v1 = o1[i] + f * oc1[i];
                float ss = allred16(v0 * v0 + v1 * v1); ss += __shfl_xor(ss, 16);
                const float rstd = rsqrtf(ss * (1.f / 64.f) + 1e-6f);
                const size_t tok = (size_t)tok0 + qi;
                const float g0 = bf2f(gq0[i]), g1 = bf2f(gq1[i]);
                MX[tok * 1024 + h * 64 + r] = (bf16_t)f2bf(g0 * sigmoidf_(g0) * v0 * rstd * ng0); MX[tok * 1024 + h * 64 + 32 + r] = (bf16_t)f2bf(g1 * sigmoidf_(g1) * v1 * rstd * ng1); }
        }
        asm volatile("" ::: "memory");
    }
}
PH_FN void ph_rwkv_post(ArgsR a, int L) {
    const int tid = ltid(), lane = tid & 63, wave = tid >> 6, c4 = 4 * lane;
    const bf16_t* RW_R = (const bf16_t*)(a.ws + WS_NB); const bf16_t* RW_KM = RW_R + (size_t)TT * 256; const bf16_t* RW_V = RW_KM + (size_t)TT * 256;
    const bf16_t* RW_G = (const bf16_t*)(a.ws + WS_PJ + 240 * MiB); bf16_t* MX = (bf16_t*)(a.ws + WS_MX);
    const f32x4 rk = *(const f32x4*)(a.in[15] + L * 256 + c4), lw = *(const f32x4*)(a.in[16] + L * 256 + c4), lb = *(const f32x4*)(a.in[17] + L * 256 + c4);
    for (int tok = blockIdx.x * 8 + wave; tok < TT; tok += gridDim.x * 8) { const size_t idx = (size_t)tok * 256 + c4; bf16_t* yp = MX + (size_t)tok * 1024 + 768 + c4;
        const f32x4 y = bf4(*(const u32x2*)yp), r = bf4(*(const u32x2*)(RW_R + idx)), km = bf4(*(const u32x2*)(RW_KM + idx)), v = bf4(*(const u32x2*)(RW_V + idx)), g = bf4(*(const u32x2*)(RW_G + idx));
        const float mean = allred16((y.x + y.y) + (y.z + y.w)) * (1.f / 64.f); const f32x4 d = y - mean;
        const float var = allred16((d.x * d.x + d.y * d.y) + (d.z * d.z + d.w * d.w)) * (1.f / 64.f);
        const f32x4 t = r * km * rk; const float bon = allred16((t.x + t.y) + (t.z + t.w));
        const f32x4 o = (d * rsqrtf(var + 64e-5f) * lw + lb + v * bon) * g;
        *(u32x2*)yp = (u32x2){pk2(o.x, o.y), pk2(o.z, o.w)}; }
}
#define XB_TMO      128
#define XB_XCNT(j)  (256  + 64 * (j))
#define XB_XSUB(j)  (1280 + 64 * (j))
#define XB_XGEN(j)  (2304 + 64 * (j))
#define XB_TOP      3328
#define XB_TOPGEN   3392
#define XCD_BAR_WORDS 3456
#define XB_SPIN_CAP (1u << 18)

__device__ __forceinline__ unsigned xb_ld(unsigned* p)              { return __hip_atomic_load(p, __ATOMIC_RELAXED, __HIP_MEMORY_SCOPE_AGENT); }
__device__ __forceinline__ unsigned xb_add(unsigned* p, unsigned v) { return __hip_atomic_fetch_add(p, v, __ATOMIC_RELAXED, __HIP_MEMORY_SCOPE_AGENT); }
__device__ __forceinline__ unsigned xb_xcc_id() { return (unsigned)__builtin_amdgcn_s_getreg((3 << 11) | 20) & 0xFu; }
#define XB_SPIN(cond, bar) do { unsigned _sp = 0; while (cond) { __builtin_amdgcn_s_sleep(1); \
    if ((++_sp & 255u) == 0u) { if (xb_ld(&(bar)[XB_TMO])) break; if (_sp > XB_SPIN_CAP) { atomicAdd(&(bar)[XB_TMO], 1u); break; } } } } while (0)

struct XcdBarrier {
    unsigned* bar; unsigned x;
    volatile LAS unsigned* st;
};

__device__ __forceinline__ XcdBarrier xcd_barrier_post(unsigned* bar, volatile LAS unsigned* st) {
    XcdBarrier b; b.bar = bar; b.x = xb_xcc_id(); b.st = st;
    if (threadIdx.x == 0) (void)xb_add(&bar[XB_XCNT(b.x)], 1u);
    return b;
}
__device__ __forceinline__ void xcd_barrier_complete(unsigned* bar, unsigned x, unsigned& nloc, unsigned& nx) {
    const unsigned G = gridDim.x * gridDim.y * gridDim.z;
    unsigned sum, cnt, mine, sp = 0u;
    for (;;) {
        sum = 0u; cnt = 0u; mine = 0u;
#pragma unroll
        for (unsigned j = 0; j < 16; ++j) { const unsigned c = xb_ld(&bar[XB_XCNT(j)]); sum += c; cnt += (c > 0u) ? 1u : 0u; mine = (j == x) ? c : mine; }
        if (sum == G) break;
        __builtin_amdgcn_s_sleep(1);
        if ((++sp & 255u) == 0u) { if (xb_ld(&bar[XB_TMO])) break; if (sp > XB_SPIN_CAP) { atomicAdd(&bar[XB_TMO], 1u); break; } }
    }
    nloc = mine > 0u ? mine : 1u; nx = cnt > 0u ? cnt : 1u;
}

__device__ __forceinline__ void xcd_barrier(const XcdBarrier& b) {
    asm volatile("s_waitcnt vmcnt(0)" ::: "memory");
    __syncthreads();
    if (threadIdx.x == 0) {
        unsigned* bar = b.bar;
        __builtin_amdgcn_s_waitcnt(0);
        unsigned nloc = b.st[0], nx = b.st[1];
        if (nloc == 0u) { xcd_barrier_complete(bar, b.x, nloc, nx); b.st[0] = nloc; b.st[1] = nx; }
        const unsigned old = xb_add(&bar[XB_XSUB(b.x)], 1u);
        const unsigned gen = old / nloc;
        if (old + 1u == (gen + 1u) * nloc) {
            __builtin_amdgcn_fence(__ATOMIC_RELEASE, "agent");
            asm volatile("s_waitcnt vmcnt(0)" ::: "memory");
            const unsigned og = xb_add(&bar[XB_TOP], 1u);
            const unsigned tg = og / nx;
            if (og + 1u == (tg + 1u) * nx) xb_add(&bar[XB_TOPGEN], 1u);
            else XB_SPIN(xb_ld(&bar[XB_TOPGEN]) == tg, bar);
            __builtin_amdgcn_fence(__ATOMIC_ACQUIRE, "agent");
            xb_add(&bar[XB_XGEN(b.x)], 1u);
            asm volatile("s_waitcnt vmcnt(0)" ::: "memory");
        } else {
            XB_SPIN(xb_ld(&bar[XB_XGEN(b.x)]) == gen, bar);
            __builtin_amdgcn_fence(__ATOMIC_ACQUIRE, "agent");
            asm volatile("s_waitcnt vmcnt(0)" ::: "memory");
        }
    }
    __syncthreads();
}
#ifndef EN_MASK
#define EN_MASK 0xffff
#endif
#define EN(i) ((EN_MASK >> (i)) & 1)
#ifndef REP_MASK
#define REP_MASK 0
#endif
#define REP(i) (((REP_MASK >> (i)) & 1) ? 2 : 1)
#ifndef MK_PER_PHASE
#define MK_PER_PHASE 0
#endif
__global__ void __launch_bounds__(512, 2) mk_fwd(Args a_) {
    extern __shared__ __attribute__((aligned(16))) unsigned char lds_raw[];
    LAS unsigned char* lds = (LAS unsigned char*)lds_raw;
    const int G = gridDim.x, bid = blockIdx.x;
    const int ph_lo = a_.ph_lo, ph_hi = a_.ph_hi;
    volatile LAS unsigned* bst = (volatile LAS unsigned*)(lds + LDS_BYTES - 256);
    if (threadIdx.x < 2) bst[threadIdx.x] = 0u;
    __syncthreads();
    XcdBarrier xbar = xcd_barrier_post((unsigned*)(a_.ws + WS_CTL) + 1024, bst);
    for (int ph = ph_lo; ph < ph_hi; ++ph) {
        const __attribute__((address_space(4))) Args* ap = (const __attribute__((address_space(4))) Args*)__builtin_amdgcn_kernarg_segment_ptr();
        asm volatile("" : "+s"(ap));
        ArgsR a = *ap;
        bf16_t* WB = (bf16_t*)(a.ws + WS_WB); bf16_t* NB = (bf16_t*)(a.ws + WS_NB); bf16_t* PJ = (bf16_t*)(a.ws + WS_PJ); bf16_t* MX = (bf16_t*)(a.ws + WS_MX); bf16_t* PB = (bf16_t*)(a.ws + WS_KV);
        int ngemm = 0; pg8::Gemm g0{nullptr, nullptr, 0, 0, 0}; pg8::EpiGen e0{0, true, nullptr, 0, nullptr, nullptr, nullptr, nullptr, nullptr, nullptr};
        unsigned long long* RSS = (unsigned long long*)(a.ws + WS_RSS);
        if (ph == 0) { if (EN(11)) ph_prologue(a); }
        else if (ph == NPHASE - 1) { if (EN(12)) ph_final(RSS + 12 * TT, a.in[23], a.out); }
        else {
            const int L = (ph - 1) / NSUB, s = (ph - 1) % NSUB;
            const int wrem = ((TT / 256) * (INW / 256)) % G;
            if (s == 0) { ph_weights(a, L, lds, wrem ? 0 : 2, bid, G); }
            else if (s == 1) { ngemm = 1; g0 = pg8::Gemm{MX, WB + WB_IN, TT, INW, DM}; e0 = pg8::EpiGen{0, true, PJ, INW, nullptr, nullptr, nullptr, nullptr, RSS + (3 * L) * TT, nullptr}; }
            else if (s == 2) { _Pragma("nounroll") for (int rp = 0; rp < REP(2); ++rp) ph_ret_kv(a, lds); __syncthreads();     _Pragma("nounroll") for (int rp = 0; rp < REP(15); ++rp) ph_rwkv_prep(a, L, lds); }
            else if (s == 3) { { _Pragma("nounroll") for (int rp = 0; rp < REP(3); ++rp) for (int u = bid; u < 8 * (SC_NC - 1); u += G) ph_scan_pass<1>(a, lds, u, L); } }
            else if (s == 4) { if (bid < 32) ph_scan_combine(a, lds, bid); else { if (bid >= G - 64) ph_ret_scan(a, bid - (G - 64)); _Pragma("nounroll") for (int rp = 0; rp < REP(13); ++rp) ph_sb(a, L, bid - 32, G - 32); } }
            else if (s == 5) { _Pragma("nounroll") for (int rp = 0; rp < REP(14); ++rp) for (int u = bid; u < 8 * SC_NC; u += G) ph_scan_pass<2>(a, lds, u, L); }
            else if (s == 6) { _Pragma("nounroll") for (int rp = 0; rp < REP(4); ++rp) ph_ret_out(a, L, lds); }
            else if (s == 7) { ph_pconv(a.in[1] + (size_t)L * TT * PLE, PB); ngemm = 1; g0 = pg8::Gemm{MX, WB + WB_O, TT, DM, DM}; e0 = pg8::EpiGen{2, true, nullptr, DM, L == 0 ? a.in[0] : a.out, a.out, NB, nullptr, nullptr, RSS + (3 * L + 1) * TT}; }
            else if (s == 8) { ngemm = 2; g0 = pg8::Gemm{NB, WB + WB_1, TT, DFF, DM}; e0 = pg8::EpiGen{1, true, PJ, DFF, nullptr, nullptr, nullptr, nullptr, RSS + (3 * L + 1) * TT, nullptr};
 }
            else if (s == 9) { ngemm = 1; g0 = pg8::Gemm{PJ, WB + WB_2, TT, DM, DFF}; e0 = pg8::EpiGen{2, true, nullptr, DM, a.out, a.out, NB, nullptr, nullptr, RSS + (3 * L + 2) * TT}; }
            else { ngemm = 1; g0 = pg8::Gemm{NB, WB + WB_PG, TT, DM, DM}; e0 = pg8::EpiGen{3, true, nullptr, DM, a.out, a.out, MX, MX, RSS + (3 * L + 2) * TT, RSS + (3 * L + 3) * TT}; }
        }
        const int grep_ = 1;
        for (int gi = 0; gi < ngemm * grep_; ++gi) {
            pg8::Gemm g = g0; pg8::EpiGen E = e0;
            if (gi % ngemm) { const __attribute__((address_space(4))) Args* ap2 = (const __attribute__((address_space(4))) Args*)__builtin_amdgcn_kernarg_segment_ptr(); asm volatile("" : "+s"(ap2));
                unsigned char* ws2 = ap2->ws; g = pg8::Gemm{(bf16_t*)(ws2 + WS_KV), (bf16_t*)(ws2 + WS_WB) + WB_PE, TT, DM, PLE}; E = pg8::EpiGen{0, true, (bf16_t*)(ws2 + WS_MX), DM, nullptr, nullptr, nullptr, nullptr, nullptr, nullptr}; }
            pg8::StaticOrder S; S.init(g.M, g.N, G, bid);
            pg8::gemm_phase<pg8::EpiGen, pg8::StaticOrder, true, true>(lds, g, S, E);
            __syncthreads();
        }
        if (ph > 0 && ph < NPHASE - 1 && ((ph - 1) % NSUB) == 1) { const int wrem2 = ((TT / 256) * (INW / 256)) % G; if (wrem2 && bid >= wrem2) ph_weights(a, (ph - 1) / NSUB, lds, 1, bid - wrem2, G - wrem2); }
        if (ph + 1 < ph_hi) { if (ph == ph_lo) cg::this_grid().sync(); else xcd_barrier(xbar); }
    }
}

extern "C" void kernel_launch(void* const* d_in, const int* in_sizes, int n_in, void* d_out, int out_size, void* d_ws, size_t ws_size, hipStream_t stream) {
    static int grid = 0;
    if (grid == 0) {
        if (n_in != 24 || out_size != TT * DM || ws_size < WS_END) { fprintf(stderr, "kernel_launch: unexpected shapes (n_in %d, out %d, ws %zu); nothing launched\n", n_in, out_size, ws_size); grid = -1; return; }
        int dev = 0, cus = 0, per_cu = 0;
        (void)hipGetDevice(&dev); (void)hipDeviceGetAttribute(&cus, hipDeviceAttributeMultiprocessorCount, dev);
        if (hipFuncSetAttribute((const void*)mk_fwd, hipFuncAttributeMaxDynamicSharedMemorySize, LDS_BYTES) != hipSuccess) fprintf(stderr, "kernel_launch: hipFuncSetAttribute failed\n");
        if (hipOccupancyMaxActiveBlocksPerMultiprocessor(&per_cu, (const void*)mk_fwd, 512, LDS_BYTES) != hipSuccess || per_cu < 1) { fprintf(stderr, "kernel_launch: occupancy query says %d\n", per_cu); per_cu = 1; }
        (void)hipGetLastError();
        grid = cus * 1;
        if (grid <= 16) grid = 256;
    }
    if (grid < 0) return;
    (void)hipMemsetAsync((char*)d_ws + WS_CTL, 0, 65536, stream);
    Args a{};
    for (int i = 0; i < 24; ++i) a.in[i] = (const float*)d_in[i];
    a.out = (float*)d_out; a.ws = (unsigned char*)d_ws;
#if MK_PER_PHASE
    for (int ph = 0; ph < NPHASE; ++ph) { a.ph_lo = ph; a.ph_hi = ph + 1; hipLaunchKernelGGL(mk_fwd, dim3(grid), dim3(512), LDS_BYTES, stream, a); }
#else
    a.ph_lo = 0; a.ph_hi = NPHASE;
    void* args[] = {&a};
    hipError_t e = hipLaunchCooperativeKernel((void*)mk_fwd, dim3(grid), dim3(512), args, LDS_BYTES, stream);
    if (e != hipSuccess) fprintf(stderr, "cooperative launch failed: %s (grid %d)\n", hipGetErrorString(e), grid);
#endif
}
```
